# Optimizing an MI355X kernel written in HIP

```python
import jax, jax.numpy as jnp
from jax import lax
import numpy as np

D_MODEL = 1024
BATCH = 8
SEQ = 8192
DEPTH = 2

EXPAND = 2
MIX_WIDTH = EXPAND * D_MODEL
GMLP_WIDTH = MIX_WIDTH // 2
GMLP_GROUPS = 4
GMLP_GROUP_DIM = GMLP_WIDTH // GMLP_GROUPS
GMLP_CHUNK = 128
ATTN_WIDTH = MIX_WIDTH // 2
HEAD_DIM = 128
N_Q_HEADS = ATTN_WIDTH // HEAD_DIM
N_KV_HEADS = 2
GQA_GROUP = N_Q_HEADS // N_KV_HEADS
KV_WIDTH = N_KV_HEADS * HEAD_DIM
WINDOW = 128
ATTN_BLOCK = 128
HGRN_WIDTH = MIX_WIDTH
HGRN_HEAD_DIM = 128
HGRN_HEADS = HGRN_WIDTH // HGRN_HEAD_DIM
HGRN_CHUNK = 64

EPS = 1e-6
N_EVEN = (DEPTH + 1) // 2
N_ODD = DEPTH // 2
EVEN_SPLITS = [GMLP_WIDTH, GMLP_WIDTH, GMLP_WIDTH, ATTN_WIDTH, KV_WIDTH, KV_WIDTH, ATTN_WIDTH]
ODD_SPLITS = [HGRN_WIDTH] * 5
IN_EVEN = sum(EVEN_SPLITS)
IN_ODD = sum(ODD_SPLITS)

kernel_name = "hybrid_gmlp_swa_hgrn2_encoder"

F32 = jnp.float32


def rms_norm(x, g):
    xf = x.astype(F32)
    y = xf * lax.rsqrt(jnp.mean(xf * xf, axis=-1, keepdims=True) + EPS)
    return (y * g.astype(F32)).astype(x.dtype)


def split_cols(t, sizes):
    idx = [int(i) for i in np.cumsum(sizes)[:-1]]
    return jnp.split(t, idx, axis=-1)


def alibi_slopes(n):
    return jnp.exp2(-8.0 * jnp.arange(1, n + 1, dtype=F32) / n)


def chunked_sgu(u, v, ln_g, ln_b, w_s, b_s):
    B, S, _ = v.shape
    vf = v.astype(F32)
    mu = jnp.mean(vf, axis=-1, keepdims=True)
    var = jnp.mean(jnp.square(vf - mu), axis=-1, keepdims=True)
    vn = ((vf - mu) * lax.rsqrt(var + EPS) * ln_g.astype(F32) + ln_b.astype(F32)).astype(v.dtype)
    vc = vn.reshape(B, S // GMLP_CHUNK, GMLP_CHUNK, GMLP_GROUPS, GMLP_GROUP_DIM)
    mixed = jnp.einsum('gts,bnsgc->bntgc', w_s, vc) + b_s.T[None, None, :, :, None]
    return u * mixed.reshape(B, S, GMLP_WIDTH)


def window_attention(q, k, v, sink):
    B, S = q.shape[0], q.shape[1]
    nb = S // ATTN_BLOCK
    qb = q.reshape(B, nb, ATTN_BLOCK, N_KV_HEADS, GQA_GROUP, HEAD_DIM)

    def band(t):
        tp = jnp.pad(t, ((0, 0), (ATTN_BLOCK, ATTN_BLOCK), (0, 0), (0, 0)))
        tb = tp.reshape(B, nb + 2, ATTN_BLOCK, N_KV_HEADS, HEAD_DIM)
        return jnp.concatenate([tb[:, :-2], tb[:, 1:-1], tb[:, 2:]], axis=2)

    kb, vb = band(k), band(v)
    scores = jnp.einsum('bnqhgd,bnshd->bnhgqs', qb, kb).astype(F32) * (HEAD_DIM ** -0.5)
    qi = jnp.arange(ATTN_BLOCK)
    kj = jnp.arange(3 * ATTN_BLOCK) - ATTN_BLOCK
    dist = jnp.abs(kj[None, :] - qi[:, None])
    kpos = (jnp.arange(nb) * ATTN_BLOCK)[:, None] + kj[None, :]
    valid = (dist[None] <= WINDOW) & (kpos[:, None, :] >= 0) & (kpos[:, None, :] < S)
    slopes = alibi_slopes(N_Q_HEADS).reshape(N_KV_HEADS, GQA_GROUP)
    scores = scores - slopes[:, :, None, None] * dist.astype(F32)
    scores = jnp.where(valid[None, :, None, None], scores, -jnp.inf)
    sink_l = sink.astype(F32).reshape(N_KV_HEADS, GQA_GROUP)[None, None, :, :, None, None]
    m = jnp.maximum(jnp.max(scores, axis=-1, keepdims=True), sink_l)
    p = jnp.exp(scores - m)
    p = p / (jnp.sum(p, axis=-1, keepdims=True) + jnp.exp(sink_l - m))
    out = jnp.einsum('bnhgqs,bnshd->bnqhgd', p.astype(v.dtype), vb)
    return out.reshape(B, S, N_Q_HEADS * HEAD_DIM)


def hgrn2_direction(q, f_logit, i, lb):
    B, S, H, D = q.shape
    nc = S // HGRN_CHUNK
    C = HGRN_CHUNK
    f = lb + (1.0 - lb) * jax.nn.sigmoid(f_logit.astype(F32))
    k = 1.0 - f
    g = jnp.log(f)

    def chunk(t):
        return t.reshape(B, nc, C, H, D)

    qc, kc, vc, gc = chunk(q.astype(F32)), chunk(k), chunk(i.astype(F32)), chunk(g)
    bcum = jnp.cumsum(gc, axis=2)
    blast = bcum[:, :, -1:]
    q_t = qc * jnp.exp(bcum)
    k_t = kc * jnp.exp(-bcum)
    k_end = kc * jnp.exp(blast - bcum)
    a = jnp.einsum('bnthd,bnshd->bnhts', q_t, k_t)
    a = jnp.where(jnp.tril(jnp.ones((C, C), dtype=bool)), a, 0.0)
    o_intra = jnp.einsum('bnhts,bnshv->bnthv', a, vc)

    def step(state, xs):
        qn, kn, vn, dn = xs
        o = jnp.einsum('bthd,bhdv->bthv', qn, state)
        state = state * dn[..., None] + jnp.einsum('bshd,bshv->bhdv', kn, vn)
        return state, o

    xs = (jnp.moveaxis(q_t, 1, 0), jnp.moveaxis(k_end, 1, 0), jnp.moveaxis(vc, 1, 0),
          jnp.moveaxis(jnp.exp(blast[:, :, 0]), 1, 0))
    s0 = jnp.zeros((B, H, D, D), dtype=F32)
    _, o_inter = lax.scan(step, s0, xs)
    o = o_intra + jnp.moveaxis(o_inter, 0, 1)
    return o.reshape(B, S, H, D)


def hgrn_lower_bound(gamma, layer):
    c = jnp.cumsum(jax.nn.softmax(gamma.astype(F32), axis=0), axis=0)
    return (c[layer] - c[0]).reshape(HGRN_HEADS, HGRN_HEAD_DIM)


def even_layer(x, norm_g, w_in, ln_g, ln_b, w_s, b_s, sink, w_out):
    B, S, _ = x.shape
    h = rms_norm(x, norm_g)
    proj = h @ w_in
    u_a, v_a, z_a, q_b, k_b, v_b, z_b = split_cols(proj, EVEN_SPLITS)
    a_out = chunked_sgu(u_a, v_a, ln_g, ln_b, w_s, b_s) * jax.nn.silu(z_a)
    b_out = window_attention(q_b.reshape(B, S, N_Q_HEADS, HEAD_DIM),
                             k_b.reshape(B, S, N_KV_HEADS, HEAD_DIM),
                             v_b.reshape(B, S, N_KV_HEADS, HEAD_DIM), sink) * jax.nn.silu(z_b)
    return jnp.concatenate([a_out, b_out], axis=-1) @ w_out


def odd_layer(x, norm_g, w_in, gamma_f, gamma_b, head_norm_g, w_out, layer):
    B, S, _ = x.shape
    h = rms_norm(x, norm_g)
    proj = h @ w_in
    q, f_f, f_b, i, z = split_cols(proj, ODD_SPLITS)
    shp = (B, S, HGRN_HEADS, HGRN_HEAD_DIM)
    q = jax.nn.silu(q).reshape(shp)
    i = i.reshape(shp)
    o_f = hgrn2_direction(q, f_f.reshape(shp), i, hgrn_lower_bound(gamma_f, layer))
    o_b = jnp.flip(hgrn2_direction(jnp.flip(q, 1), jnp.flip(f_b.reshape(shp), 1), jnp.flip(i, 1),
                                   hgrn_lower_bound(gamma_b, layer)), 1)
    o = o_f + o_b
    o = o * lax.rsqrt(jnp.mean(o * o, axis=-1, keepdims=True) + EPS)
    o = (o.reshape(B, S, HGRN_WIDTH) * head_norm_g.astype(F32)).astype(x.dtype)
    return (o * jax.nn.silu(z)) @ w_out


def setup_inputs(seed: int = 0) -> dict:
    key = jax.random.key(seed)
    ks = jax.random.split(key, 16)
    nrm = jax.random.normal
    return {
        "x": nrm(ks[0], (BATCH, SEQ, D_MODEL), F32),
        "norm_g_even": 1.0 + 0.02 * nrm(ks[1], (N_EVEN, D_MODEL), F32),
        "w_in_even": nrm(ks[2], (N_EVEN, D_MODEL, IN_EVEN), F32) * D_MODEL ** -0.5,
        "gmlp_ln_g": 1.0 + 0.02 * nrm(ks[3], (N_EVEN, GMLP_WIDTH), F32),
        "gmlp_ln_b": 0.02 * nrm(ks[4], (N_EVEN, GMLP_WIDTH), F32),
        "gmlp_w_s": nrm(ks[5], (N_EVEN, GMLP_GROUPS, GMLP_CHUNK, GMLP_CHUNK), F32) * GMLP_CHUNK ** -0.5,
        "gmlp_b_s": 1.0 + 0.02 * nrm(ks[6], (N_EVEN, GMLP_GROUPS, GMLP_CHUNK), F32),
        "attn_sink": 0.5 * nrm(ks[7], (N_EVEN, N_Q_HEADS), F32),
        "w_out_even": nrm(ks[8], (N_EVEN, GMLP_WIDTH + ATTN_WIDTH, D_MODEL), F32) * (GMLP_WIDTH + ATTN_WIDTH) ** -0.5,
        "norm_g_odd": 1.0 + 0.02 * nrm(ks[9], (N_ODD, D_MODEL), F32),
        "w_in_odd": nrm(ks[10], (N_ODD, D_MODEL, IN_ODD), F32) * D_MODEL ** -0.5,
        "hgrn_gamma_fwd": 1.0 + 0.1 * nrm(ks[11], (DEPTH, HGRN_WIDTH), F32),
        "hgrn_gamma_bwd": 1.0 + 0.1 * nrm(ks[12], (DEPTH, HGRN_WIDTH), F32),
        "hgrn_head_norm_g": 1.0 + 0.02 * nrm(ks[13], (N_ODD, HGRN_WIDTH), F32),
        "w_out_odd": nrm(ks[14], (N_ODD, HGRN_WIDTH, D_MODEL), F32) * HGRN_WIDTH ** -0.5,
        "final_norm_g": 1.0 + 0.02 * nrm(ks[15], (D_MODEL,), F32),
    }


def reference(x, norm_g_even, w_in_even, gmlp_ln_g, gmlp_ln_b, gmlp_w_s, gmlp_b_s, attn_sink,
              w_out_even, norm_g_odd, w_in_odd, hgrn_gamma_fwd, hgrn_gamma_bwd, hgrn_head_norm_g,
              w_out_odd, final_norm_g):
    for layer in range(DEPTH):
        j = layer // 2
        if layer % 2 == 0:
            x = x + even_layer(x, norm_g_even[j], w_in_even[j], gmlp_ln_g[j], gmlp_ln_b[j],
                               gmlp_w_s[j], gmlp_b_s[j], attn_sink[j], w_out_even[j])
        else:
            x = x + odd_layer(x, norm_g_odd[j], w_in_odd[j], hgrn_gamma_fwd, hgrn_gamma_bwd,
                              hgrn_head_norm_g[j], w_out_odd[j], layer)
    return rms_norm(x, final_norm_g)
```

```cpp
#include <hip/hip_runtime.h>
#include <hip/hip_cooperative_groups.h>
#include <cstdio>
namespace cg = cooperative_groups;

#ifndef N_LAUNCH_MODE
#define N_LAUNCH_MODE 1
#endif

#ifndef PROBE_ATT2
#define PROBE_ATT2 0
#endif
#ifndef PROBE_SYNCS
#define PROBE_SYNCS 0
#endif
#ifndef REPEAT_MASK
#define REPEAT_MASK 0
#endif
#ifndef PH_SKIP
#define PH_SKIP(ph) 0
#define EXP_NOSCAN 0
#endif
#ifndef GEMM_SP2
#define GEMM_SP2 1
#endif
#define LAS __attribute__((address_space(3)))
typedef unsigned short bf16_t;
typedef short bf16x8 __attribute__((ext_vector_type(8)));
typedef float f32x4 __attribute__((ext_vector_type(4)));
typedef float f32x2 __attribute__((ext_vector_type(2)));
typedef unsigned u32x4 __attribute__((ext_vector_type(4)));
typedef unsigned u32x2 __attribute__((ext_vector_type(2)));

constexpr int MTOK = 65536, DM = 1024, SEQ = 8192, MH = 32768;
constexpr int N0 = 5376;
constexpr int N1 = 8192;
constexpr size_t MiB = 1048576;
constexpr size_t OFF_WT0 = 0;
constexpr size_t OFF_WT0O = OFF_WT0 + (size_t)5632 * 1024 * 2;
constexpr size_t OFF_WT1 = OFF_WT0O + (size_t)1024 * 2048 * 2;
constexpr size_t OFF_WT1O = OFF_WT1 + (size_t)10240 * 1024 * 2;
constexpr size_t OFF_LB = 39 * MiB;
constexpr size_t OFF_BAR = 39 * MiB + 65536;
constexpr size_t OFF_STAT = 39 * MiB + 131072;
constexpr size_t OFF_PROJ0 = 40 * MiB;
constexpr size_t OFF_VBT = 712 * MiB;
constexpr size_t OFF_H0 = 744 * MiB;
constexpr size_t OFF_MIX0 = 744 * MiB;
constexpr size_t OFF_H1 = 40 * MiB;
constexpr size_t OFF_PROJ1 = 104 * MiB;
constexpr size_t OFF_IT = 616 * MiB;
constexpr size_t OFF_OF = 744 * MiB;
constexpr size_t OFF_OB = 872 * MiB;
constexpr size_t OFF_STATP = 1000 * MiB;
constexpr size_t WS_NEED = 1008 * MiB;
constexpr int LDS_BYTES = 156672;
constexpr int NPHASE = 14;

struct Params {
    const float* x; const float* norm_g_even; const float* w_in_even; const float* ln_g; const float* ln_b; const float* w_s; const float* b_s; const float* sink; const float* w_out_even;
    const float* norm_g_odd; const float* w_in_odd; const float* gamma_f; const float* gamma_b; const float* head_g; const float* w_out_odd; const float* final_g;
    float* out; unsigned char* ws; int ph_lo, ph_hi;
};

typedef __bf16 bf16x2_t __attribute__((ext_vector_type(2)));
__device__ __forceinline__ unsigned cvt_pk_bf16(float lo, float hi) { f32x2 v = {lo, hi}; bf16x2_t b = __builtin_convertvector(v, bf16x2_t); return __builtin_bit_cast(unsigned, b); }
__device__ __forceinline__ float bf_lo(unsigned w) { return __uint_as_float(w << 16); }
__device__ __forceinline__ float bf_hi(unsigned w) { return __uint_as_float(w & 0xffff0000u); }
__device__ __forceinline__ float sigmoidf_(float x) { return __builtin_amdgcn_rcpf(1.0f + __expf(-x)); }
__device__ __forceinline__ float siluf_(float x) { return x * sigmoidf_(x); }
__device__ __forceinline__ int tid_op() { int t = threadIdx.x; asm volatile("" : "+v"(t)); return t; }
__device__ __forceinline__ int bid_op() { int b = blockIdx.x; asm volatile("" : "+s"(b)); return b; }
__device__ __forceinline__ int img_off(int row, int chunk, int sub) { return chunk * sub + ((row ^ (chunk & 7)) << 4); }
#define FRAG_BASE(sub, par) (quad * (sub) + ((l15 ^ (quad + 4 * (par))) << 4))
__device__ __forceinline__ void store16_stream(void* p, u32x4 v) { asm volatile("global_store_dwordx4 %0, %1, off sc1 nt\n\ts_nop 1" :: "v"(p), "v"(v) : "memory"); }
__device__ __forceinline__ f32x4 mfma16(bf16x8 a, bf16x8 b, f32x4 c) { return __builtin_amdgcn_mfma_f32_16x16x32_bf16(a, b, c, 0, 0, 0); }

namespace pg8 {
constexpr int BM = 256, BK = 64, HALF = 128, HTB = HALF * BK * 2, STAGE_BYTES = 8 * HTB, NXCD = 8, WGM = 4;
__device__ __forceinline__ int lds_byte(int r, int c) { const int st = (r >> 4) * 2 + (c >> 5), rr = r & 15, cc = c & 31, ob = rr * 64 + cc * 2; return st * 1024 + (ob ^ (((ob >> 9) & 1) << 5)); }
__device__ __forceinline__ void stage_rc(int b, int& R, int& C) { const int st = b / 1024, sb = b % 1024, swz = sb ^ (((sb >> 9) & 1) << 5); R = (st >> 1) * 16 + swz / 64; C = (st & 1) * 32 + (swz % 64) / 2; }
__device__ __forceinline__ int perm32(int rho) { const int n = rho >> 4, i = rho & 15; return 8 * (i >> 2) + 4 * n + (i & 3); }
struct Unit { int pm, pn; };
struct Gemm { const bf16_t* A; const bf16_t* Bt; int M, N, K; };
struct StaticOrder {
    int nM, nN, nwg, G, c;
    __device__ void init(int M, int N, int G_, int c_) { nM = M / BM; nN = N / BM; nwg = nM * nN; G = G_; c = c_; }
    __device__ bool next(int i, Unit& u) const {
        const long L = (long)i * G + c; if (L >= nwg) return false;
        int wgid = (int)L; { const int q = nwg / NXCD, r = nwg % NXCD, xcd = wgid % NXCD, off = wgid / NXCD; wgid = (xcd < r ? xcd * (q + 1) : r * (q + 1) + (xcd - r) * q) + off; }
        const int nig = WGM * nN, gid = wgid / nig, fm = gid * WGM, gsz = (nM - fm) < WGM ? (nM - fm) : WGM;
        u.pm = fm + ((wgid % nig) % gsz); u.pn = (wgid % nig) / gsz; return true;
    }
};
struct Epi {
    int mode;
    bf16_t* O; int ldo; int silu_cols;
    const float* lbv; int f_lo, f_hi;
    float* statp; int s_lo, s_hi;
    float* C; const float* R; int ldc;
    __device__ __forceinline__ void operator()(const f32x4 (&acc)[2][2][4][2], const Unit& u, int wr, int wc, int fr, int fq) const {
        const int row0 = u.pm * BM + wr * 64 + fr, col0 = u.pn * BM + wc * 32 + 8 * fq;
        if (mode == 0) {
            const bool act = (u.pn * BM) < silu_cols, isf = (u.pn * BM) >= f_lo && (u.pn * BM) < f_hi, dostat = (u.pn * BM) >= s_lo && (u.pn * BM) < s_hi;
#pragma unroll
            for (int ai = 0; ai < 2; ++ai)
#pragma unroll
                for (int m = 0; m < 4; ++m) { bf16_t* rowp = O + (size_t)(row0 + ai * HALF + m * 16) * ldo + col0;
#pragma unroll
                    for (int bj = 0; bj < 2; ++bj) { f32x4 v0 = acc[ai][bj][m][0], v1 = acc[ai][bj][m][1];
                        if (act) {
#pragma unroll
                            for (int j = 0; j < 4; ++j) { v0[j] = siluf_(v0[j]); v1[j] = siluf_(v1[j]); } }
                        if (isf) { const f32x4 l0 = *(const f32x4*)(lbv + col0 + bj * HALF - f_lo), l1 = *(const f32x4*)(lbv + col0 + bj * HALF - f_lo + 4);
#pragma unroll
                            for (int j = 0; j < 4; ++j) { v0[j] = l0[j] + (1.0f - l0[j]) * sigmoidf_(v0[j]); v1[j] = l1[j] + (1.0f - l1[j]) * sigmoidf_(v1[j]); } }
                        u32x4 w; w.x = cvt_pk_bf16(v0[0], v0[1]); w.y = cvt_pk_bf16(v0[2], v0[3]); w.z = cvt_pk_bf16(v1[0], v1[1]); w.w = cvt_pk_bf16(v1[2], v1[3]);
                        store16_stream(rowp + bj * HALF, w); }
                    if (dostat) {
                        float s_ = 0.f, ss = 0.f;
#pragma unroll
                        for (int bj = 0; bj < 2; ++bj)
#pragma unroll
                            for (int n = 0; n < 2; ++n)
#pragma unroll
                                for (int j = 0; j < 4; ++j) { const float x = acc[ai][bj][m][n][j]; s_ += x; ss += x * x; }
                        s_ += __shfl_xor(s_, 16); ss += __shfl_xor(ss, 16); s_ += __shfl_xor(s_, 32); ss += __shfl_xor(ss, 32);
                        if (fq == 0) *(f32x2*)(statp + ((size_t)(row0 + ai * HALF + m * 16) * 16 + ((u.pn * BM - s_lo) >> 8) * 4 + wc) * 2) = (f32x2){s_, ss}; } }
        } else {
#pragma unroll
            for (int ai = 0; ai < 2; ++ai)
#pragma unroll
                for (int m = 0; m < 4; ++m) { const size_t o = (size_t)(row0 + ai * HALF + m * 16) * ldc + col0;
#pragma unroll
                    for (int bj = 0; bj < 2; ++bj) {
                        const f32x4 r0 = *(const f32x4*)(R + o + bj * HALF), r1 = *(const f32x4*)(R + o + bj * HALF + 4);
                        *(f32x4*)(C + o + bj * HALF) = r0 + acc[ai][bj][m][0]; *(f32x4*)(C + o + bj * HALF + 4) = r1 + acc[ai][bj][m][1]; } }
        }
    }
};

__device__ __forceinline__ void gemm_phase(LAS unsigned char* lds, const Gemm g, const StaticOrder& S, const Epi& E) {
    const int tid = tid_op(), wid = __builtin_amdgcn_readfirstlane(tid >> 6), lane = tid & 63, wr = wid >> 2, wc = wid & 3, fr = lane & 15, fq = lane >> 4;
    const int K = g.K, nt = K / BK;
    unsigned voffA[2], voffB[2];
#pragma unroll
    for (int i = 0; i < 2; ++i) { int R, C; stage_rc(tid * 16 + i * 8192, R, C); const int Rb = (R & ~31) + perm32(R & 31);
        voffA[i] = (unsigned)(R * K + C) * 2u; voffB[i] = (unsigned)(Rb * K + C) * 2u; }
    const size_t kstep = (size_t)(BK * 2);
    const size_t hstep = (size_t)HALF * K * 2;
    const size_t tstep = 2 * hstep;
    const unsigned ldsw = (unsigned)wid * 1024u;
    const int aoff = lds_byte(wr * 64 + fr, fq * 8), boff = lds_byte(wc * 32 + fr, fq * 8);
#define PG8_SA(b, h) (((b) * 2 + (h)) * HTB)
#define PG8_SB(b, h) ((4 + (b) * 2 + (h)) * HTB)
#define PG8_STAGE(bufoff, gbase, voff) do { _Pragma("unroll") for (int _i = 0; _i < 2; ++_i) \
        __builtin_amdgcn_global_load_lds((const unsigned*)((const char*)(gbase) + (voff)[_i]), (LAS unsigned*)(lds + (bufoff) + ldsw + _i * 8192), 16, 0, 0); } while (0)
#define PG8_LDA(dst, b, h) do { _Pragma("unroll") for (int m = 0; m < 4; ++m) _Pragma("unroll") for (int k = 0; k < 2; ++k) dst[m][k] = *(const LAS bf16x8*)(lds + PG8_SA(b, h) + aoff + m * 2048 + k * 1024); } while (0)
#define PG8_LDB(dst, b, h) do { _Pragma("unroll") for (int n = 0; n < 2; ++n) _Pragma("unroll") for (int k = 0; k < 2; ++k) dst[n][k] = *(const LAS bf16x8*)(lds + PG8_SB(b, h) + boff + n * 2048 + k * 1024); } while (0)
#define PG8_MMA(ai, bj, At, Bt) do { __builtin_amdgcn_s_setprio(1); _Pragma("unroll") for (int m = 0; m < 4; ++m) _Pragma("unroll") for (int n = 0; n < 2; ++n) _Pragma("unroll") for (int k = 0; k < 2; ++k) \
        acc[ai][bj][m][n] = __builtin_amdgcn_mfma_f32_16x16x32_bf16(Bt[n][k], At[m][k], acc[ai][bj][m][n], 0, 0, 0); __builtin_amdgcn_s_setprio(0); } while (0)
#define PG8_WAIT_V(n) asm volatile("s_waitcnt vmcnt(" #n ")" ::: "memory")
#define PG8_WAIT_L(n) asm volatile("s_waitcnt lgkmcnt(" #n ")" ::: "memory")
#define PG8_BAR __builtin_amdgcn_s_barrier()
#define PG8_SCHED __builtin_amdgcn_sched_barrier(0)
    Unit cur, nxt; int ui = 0;
    if (!S.next(0, cur)) return;
    f32x4 acc[2][2][4][2];
#pragma unroll
    for (int a = 0; a < 2; ++a)
#pragma unroll
        for (int b = 0; b < 2; ++b)
#pragma unroll
            for (int m = 0; m < 4; ++m)
#pragma unroll
                for (int n = 0; n < 2; ++n) acc[a][b][m][n] = (f32x4){0.f, 0.f, 0.f, 0.f};
    bf16x8 At[4][2], B0[2][2], B1[2][2];
    const char* cA = (const char*)g.A + (size_t)cur.pm * tstep; const char* cB = (const char*)g.Bt + (size_t)cur.pn * tstep;
#if GEMM_SP2
    PG8_STAGE(PG8_SB(0, 0), cB, voffB); PG8_STAGE(PG8_SB(0, 1), cB + hstep, voffB); PG8_STAGE(PG8_SA(0, 0), cA, voffA); PG8_STAGE(PG8_SA(0, 1), cA + hstep, voffA);
    if (wr == 1) PG8_BAR;
    PG8_WAIT_V(2); PG8_BAR;
#else
    PG8_STAGE(PG8_SB(0, 0), cB, voffB); PG8_STAGE(PG8_SA(0, 0), cA, voffA); PG8_STAGE(PG8_SB(0, 1), cB + hstep, voffB); PG8_STAGE(PG8_SA(0, 1), cA + hstep, voffA);
    if (wr == 1) PG8_BAR;
    PG8_WAIT_V(4); PG8_BAR;
#endif
    PG8_STAGE(PG8_SB(1, 0), cB + kstep, voffB); PG8_STAGE(PG8_SA(1, 0), cA + kstep, voffA); PG8_STAGE(PG8_SB(1, 1), cB + hstep + kstep, voffB);
    PG8_WAIT_V(6); PG8_BAR;
    for (;;) {
        const bool has_next = S.next(ui + 1, nxt);
        const char* nA = has_next ? (const char*)g.A + (size_t)nxt.pm * tstep : cA; const char* nB = has_next ? (const char*)g.Bt + (size_t)nxt.pn * tstep : cB;
        for (int t = 0; t < nt; t += 2) {
            const bool last = (t == nt - 2);
            const char* a1 = cA + (size_t)(t + 1) * kstep;
            const char* a2 = last ? nA : cA + (size_t)(t + 2) * kstep; const char* b2 = last ? nB : cB + (size_t)(t + 2) * kstep;
            const char* a3 = a2 + kstep; const char* b3 = b2 + kstep;
#if GEMM_SP2
            PG8_LDB(B0, 0, 0); PG8_LDB(B1, 0, 1); PG8_SCHED; PG8_LDA(At, 0, 0); PG8_STAGE(PG8_SA(1, 1), a1 + hstep, voffA);
            PG8_WAIT_V(8); PG8_WAIT_L(0); PG8_BAR; PG8_MMA(0, 0, At, B0); PG8_MMA(0, 1, At, B1); PG8_BAR; PG8_SCHED;
            PG8_LDA(At, 0, 1); PG8_STAGE(PG8_SB(0, 0), b2, voffB); PG8_STAGE(PG8_SB(0, 1), b2 + hstep, voffB); PG8_STAGE(PG8_SA(0, 0), a2, voffA);
            PG8_WAIT_V(8); PG8_WAIT_L(0); PG8_BAR; PG8_MMA(1, 0, At, B0); PG8_MMA(1, 1, At, B1); PG8_BAR; PG8_SCHED;
            PG8_LDB(B0, 1, 0); PG8_LDB(B1, 1, 1); PG8_SCHED; PG8_LDA(At, 1, 0); PG8_STAGE(PG8_SA(0, 1), a2 + hstep, voffA);
            PG8_WAIT_V(8); PG8_WAIT_L(0); PG8_BAR; PG8_MMA(0, 0, At, B0); PG8_MMA(0, 1, At, B1); PG8_BAR; PG8_SCHED;
            PG8_LDA(At, 1, 1); PG8_STAGE(PG8_SB(1, 0), b3, voffB); PG8_STAGE(PG8_SB(1, 1), b3 + hstep, voffB); PG8_STAGE(PG8_SA(1, 0), a3, voffA);
            PG8_WAIT_V(8); PG8_WAIT_L(0); PG8_BAR; PG8_MMA(1, 0, At, B0); PG8_MMA(1, 1, At, B1); PG8_BAR; PG8_SCHED;
#else
            PG8_LDB(B0, 0, 0); PG8_SCHED; PG8_LDA(At, 0, 0); PG8_STAGE(PG8_SA(1, 1), a1 + hstep, voffA);
            PG8_WAIT_L(8); PG8_BAR; PG8_WAIT_L(0); PG8_MMA(0, 0, At, B0); PG8_BAR; PG8_SCHED;
            PG8_LDB(B1, 0, 1); PG8_STAGE(PG8_SB(0, 0), b2, voffB);
            PG8_BAR; PG8_WAIT_L(0); PG8_MMA(0, 1, At, B1); PG8_BAR;
            PG8_LDA(At, 0, 1); PG8_STAGE(PG8_SA(0, 0), a2, voffA);
            PG8_BAR; PG8_WAIT_L(0); PG8_MMA(1, 0, At, B0); PG8_BAR; PG8_SCHED;
            PG8_STAGE(PG8_SB(0, 1), b2 + hstep, voffB);
            PG8_WAIT_V(6); PG8_BAR; PG8_MMA(1, 1, At, B1); PG8_BAR;
            PG8_LDB(B0, 1, 0); PG8_SCHED; PG8_LDA(At, 1, 0); PG8_STAGE(PG8_SA(0, 1), a2 + hstep, voffA);
            PG8_WAIT_L(8); PG8_BAR; PG8_WAIT_L(0); PG8_MMA(0, 0, At, B0); PG8_BAR; PG8_SCHED;
            PG8_LDB(B1, 1, 1); PG8_STAGE(PG8_SB(1, 0), b3, voffB);
            PG8_BAR; PG8_WAIT_L(0); PG8_MMA(0, 1, At, B1); PG8_BAR;
            PG8_LDA(At, 1, 1); PG8_STAGE(PG8_SA(1, 0), a3, voffA);
            PG8_BAR; PG8_WAIT_L(0); PG8_MMA(1, 0, At, B0); PG8_BAR; PG8_SCHED;
            PG8_STAGE(PG8_SB(1, 1), b3 + hstep, voffB);
            PG8_WAIT_V(6); PG8_BAR; PG8_MMA(1, 1, At, B1); PG8_BAR;
#endif
        }
        if (wr == 0) PG8_BAR;
        E(acc, cur, wr, wc, fr, fq);
        if (!has_next) break;
#pragma unroll
        for (int a = 0; a < 2; ++a)
#pragma unroll
            for (int b = 0; b < 2; ++b)
#pragma unroll
                for (int m = 0; m < 4; ++m)
#pragma unroll
                    for (int n = 0; n < 2; ++n) acc[a][b][m][n] = (f32x4){0.f, 0.f, 0.f, 0.f};
        cur = nxt; cA = nA; cB = nB; ++ui;
        if (wr == 1) PG8_BAR;
    }
    PG8_WAIT_V(0);
    PG8_BAR;
#undef PG8_SA
#undef PG8_SB
#undef PG8_STAGE
#undef PG8_LDA
#undef PG8_LDB
#undef PG8_MMA
#undef PG8_WAIT_V
#undef PG8_WAIT_L
#undef PG8_BAR
#undef PG8_SCHED
}
}

__device__ __forceinline__ void prep_weights(LAS unsigned char* lds, const Params& p) {
    LAS float* t = (LAS float*)lds;
    const int tid = tid_op();
    const int G = (int)gridDim.x;
    int id = (int)blockIdx.x;
    if (id >= 4992) return;
#define PW_DECODE(id_, W_, Wt_, N_, K_, k0_, n0_, dn0_) do { int loc; \
        if ((id_) < 1408) { W_ = p.w_in_even; N_ = 5632; K_ = 1024; loc = (id_); Wt_ = (bf16_t*)(p.ws + OFF_WT0); } \
        else if ((id_) < 1920) { W_ = p.w_out_even; N_ = 1024; K_ = 2048; loc = (id_) - 1408; Wt_ = (bf16_t*)(p.ws + OFF_WT0O); } \
        else if ((id_) < 4480) { W_ = p.w_in_odd; N_ = 10240; K_ = 1024; loc = (id_) - 1920; Wt_ = (bf16_t*)(p.ws + OFF_WT1); } \
        else { W_ = p.w_out_odd; N_ = 1024; K_ = 2048; loc = (id_) - 4480; Wt_ = (bf16_t*)(p.ws + OFF_WT1O); } \
        const int nn = N_ >> 6, kt = loc / nn; n0_ = (loc - kt * nn) * 64; k0_ = kt * 64; dn0_ = n0_; \
        if ((id_) < 1408) { if (n0_ >= 4608) dn0_ = n0_ - 256; else if (n0_ >= 4352) dn0_ = n0_ + 1024; } \
        else if ((id_) >= 1920 && (id_) < 4480) { if (n0_ >= 8192) dn0_ = n0_ - 2048; else if (n0_ >= 6144) dn0_ = n0_ + 2048; } } while (0)
    const float* W; bf16_t* Wt; int N, K, k0, n0, dn0;
    PW_DECODE(id, W, Wt, N, K, k0, n0, dn0);
    f32x4 v[2];
#pragma unroll
    for (int i = 0; i < 2; ++i) { const int idx = tid + i * 512, r = idx >> 4, c4 = idx & 15; v[i] = *(const f32x4*)(W + (size_t)(k0 + r) * N + n0 + c4 * 4); }
    for (;;) {
#pragma unroll
        for (int i = 0; i < 2; ++i) { const int idx = tid + i * 512, r = idx >> 4, c4 = idx & 15;
            t[r * 65 + c4 * 4 + 0] = v[i][0]; t[r * 65 + c4 * 4 + 1] = v[i][1]; t[r * 65 + c4 * 4 + 2] = v[i][2]; t[r * 65 + c4 * 4 + 3] = v[i][3]; }
        const int id2 = id + G;
        const float* W2 = W; bf16_t* Wt2 = Wt; int N2 = N, K2 = K, k02 = k0, n02 = n0, dn02 = dn0;
        if (id2 < 4992) { PW_DECODE(id2, W2, Wt2, N2, K2, k02, n02, dn02);
#pragma unroll
            for (int i = 0; i < 2; ++i) { const int idx = tid + i * 512, r = idx >> 4, c4 = idx & 15; v[i] = *(const f32x4*)(W2 + (size_t)(k02 + r) * N2 + n02 + c4 * 4); } }
        __syncthreads();
        { const int n = tid >> 3, k8 = tid & 7;
          float e[8];
#pragma unroll
          for (int j = 0; j < 8; ++j) e[j] = t[(k8 * 8 + j) * 65 + n];
          u32x4 w; w.x = cvt_pk_bf16(e[0], e[1]); w.y = cvt_pk_bf16(e[2], e[3]); w.z = cvt_pk_bf16(e[4], e[5]); w.w = cvt_pk_bf16(e[6], e[7]);
          *(u32x4*)(Wt + (size_t)(dn0 + n) * K + k0 + k8 * 8) = w; }
        __syncthreads();
        if (id2 >= 4992) break;
        id = id2; W = W2; Wt = Wt2; N = N2; K = K2; k0 = k02; n0 = n02; dn0 = dn02;
    }
#undef PW_DECODE
}
__device__ __forceinline__ void rms_rows_bf16(const float* X, const float* g, bf16_t* H, int nrows) {
    const int tid = tid_op(), lane = tid & 63, wv = tid >> 6;
    f32x4 gg[4];
#pragma unroll
    for (int i = 0; i < 4; ++i) gg[i] = ((const f32x4*)g)[i * 64 + lane];
    for (int r0 = (blockIdx.x * 8 + wv) * 4; r0 < nrows; r0 += gridDim.x * 32) {
        f32x4 v[4][4];
#pragma unroll
        for (int q = 0; q < 4; ++q)
#pragma unroll
            for (int i = 0; i < 4; ++i) v[q][i] = __builtin_nontemporal_load((const f32x4*)(X + (size_t)(r0 + q) * 1024) + i * 64 + lane);
#pragma unroll
        for (int q = 0; q < 4; ++q) {
            float ss = 0.f;
#pragma unroll
            for (int i = 0; i < 4; ++i) ss += v[q][i][0] * v[q][i][0] + v[q][i][1] * v[q][i][1] + v[q][i][2] * v[q][i][2] + v[q][i][3] * v[q][i][3];
#pragma unroll
            for (int o = 32; o >= 1; o >>= 1) ss += __shfl_xor(ss, o);
            const float rs = rsqrtf(ss * (1.0f / 1024.0f) + 1e-6f);
#pragma unroll
            for (int i = 0; i < 4; ++i) {
                u32x2 w; w.x = cvt_pk_bf16(v[q][i][0] * rs * gg[i][0], v[q][i][1] * rs * gg[i][1]); w.y = cvt_pk_bf16(v[q][i][2] * rs * gg[i][2], v[q][i][3] * rs * gg[i][3]);
                *(u32x2*)(H + (size_t)(r0 + q) * 1024 + (i * 64 + lane) * 4) = w; }
        }
    }
}
__device__ __forceinline__ void rms_rows_f32_inplace(float* X, const float* g, int nrows) {
    const int tid = tid_op(), lane = tid & 63, wv = tid >> 6;
    f32x4 gg[4];
#pragma unroll
    for (int i = 0; i < 4; ++i) gg[i] = ((const f32x4*)g)[i * 64 + lane];
    for (int r0 = (blockIdx.x * 8 + wv) * 4; r0 < nrows; r0 += gridDim.x * 32) {
        f32x4 v[4][4];
#pragma unroll
        for (int q = 0; q < 4; ++q)
#pragma unroll
            for (int i = 0; i < 4; ++i) v[q][i] = __builtin_nontemporal_load((const f32x4*)(X + (size_t)(r0 + q) * 1024) + i * 64 + lane);
#pragma unroll
        for (int q = 0; q < 4; ++q) {
            float ss = 0.f;
#pragma unroll
            for (int i = 0; i < 4; ++i) ss += v[q][i][0] * v[q][i][0] + v[q][i][1] * v[q][i][1] + v[q][i][2] * v[q][i][2] + v[q][i][3] * v[q][i][3];
#pragma unroll
            for (int o = 32; o >= 1; o >>= 1) ss += __shfl_xor(ss, o);
            const float rs = rsqrtf(ss * (1.0f / 1024.0f) + 1e-6f);
#pragma unroll
            for (int i = 0; i < 4; ++i) ((f32x4*)(X + (size_t)(r0 + q) * 1024))[i * 64 + lane] = v[q][i] * rs * gg[i];
        }
    }
}

__device__ __forceinline__ void att_phase(LAS unsigned char* lds, const Params& p) {
    const int tid = tid_op(), w = tid >> 6, lane = tid & 63, l15 = lane & 15, quad = lane >> 4;
    const bf16_t* proj0 = (const bf16_t*)(p.ws + OFF_PROJ0); const bf16_t* vbt = (const bf16_t*)(p.ws + OFF_VBT); bf16_t* mix0 = (bf16_t*)(p.ws + OFF_MIX0);
    LAS unsigned char* Ks = lds; LAS unsigned char* Vs = lds + 32768; LAS unsigned char* Ps = lds + 65536;
    const float scale = 0.08838834764831845f;
    const int tl = w * 16 + l15;
    const int fb0 = FRAG_BASE(2048, 0), fb1 = FRAG_BASE(2048, 1);
    const int G = (int)gridDim.x;
    int it = (int)blockIdx.x;
    if (it >= 4096) return;
    u32x4 kreg[4], vreg[4]; bf16x8 qnext[4];
#define ATT_LOADKV(b_, nb_, hk_) do { const size_t _st = (size_t)(b_) * SEQ + (size_t)(nb_) * 128; \
        _Pragma("unroll") for (int i = 0; i < 4; ++i) { const int idx = tid + i * 512, r = idx >> 4, c = idx & 15; \
            kreg[i] = *(const u32x4*)(proj0 + (_st + r) * N0 + 4096 + (hk_) * 128 + c * 8); \
            vreg[i] = *(const u32x4*)(vbt + (size_t)((hk_) * 128 + r) * MTOK + _st + c * 8); } } while (0)
#define ATT_LOADQ(b_, n_, hq_) do { const bf16_t* qp = proj0 + ((size_t)(b_) * SEQ + (size_t)(n_) * 128 + w * 16 + l15) * N0 + 3072 + (hq_) * 128 + quad * 8; \
        _Pragma("unroll") for (int k = 0; k < 4; ++k) qnext[k] = *(const bf16x8*)(qp + k * 32); } while (0)
    int b = it >> 9, n = (it >> 3) & 63, hq = it & 7;
    int kb = (n == 0) ? 0 : -1;
    ATT_LOADQ(b, n, hq); ATT_LOADKV(b, n + kb, hq >> 2);
    for (;;) {
        bf16x8 qf[4];
#pragma unroll
        for (int k = 0; k < 4; ++k) qf[k] = qnext[k];
        float m = p.sink[hq], l = 1.0f;
        f32x4 oacc[8];
#pragma unroll
        for (int i = 0; i < 8; ++i) oacc[i] = (f32x4){0.f, 0.f, 0.f, 0.f};
        const float slope = exp2f(-(float)(hq + 1));
        const int kb_last = (n == 63) ? 0 : 1;
        const int it2 = it + G;
        for (;;) {
            __syncthreads();
#pragma unroll
            for (int i = 0; i < 4; ++i) { const int idx = tid + i * 512, r = idx >> 4, c = idx & 15;
                *(LAS u32x4*)(Ks + img_off(r, c, 2048)) = kreg[i]; *(LAS u32x4*)(Vs + img_off(r, c, 2048)) = vreg[i]; }
            if (kb != kb_last) { ATT_LOADKV(b, n + kb + 1, hq >> 2); }
            else if (it2 < 4096) { const int b2 = it2 >> 9, n2 = (it2 >> 3) & 63, hq2 = it2 & 7; ATT_LOADQ(b2, n2, hq2); ATT_LOADKV(b2, n2 + ((n2 == 0) ? 0 : -1), hq2 >> 2); }
            __syncthreads();
            f32x4 sc[8];
#pragma unroll
            for (int sp = 0; sp < 4; ++sp) {
                bf16x8 kf[2][4];
#pragma unroll
                for (int i = 0; i < 2; ++i)
#pragma unroll
                    for (int k = 0; k < 4; ++k) kf[i][k] = *(const LAS bf16x8*)(Ks + ((k & 1) ? fb1 : fb0) + (sp * 2 + i) * 256 + k * 8192);
                __builtin_amdgcn_sched_barrier(0);
                f32x4 a0 = (f32x4){0.f, 0.f, 0.f, 0.f}, a1 = (f32x4){0.f, 0.f, 0.f, 0.f};
#pragma unroll
                for (int k = 0; k < 4; ++k) { a0 = mfma16(kf[0][k], qf[k], a0); a1 = mfma16(kf[1][k], qf[k], a1); }
                sc[sp * 2] = a0; sc[sp * 2 + 1] = a1;
                __builtin_amdgcn_sched_barrier(0);
            }
            float mx = -1e30f;
#pragma unroll
            for (int st = 0; st < 8; ++st)
#pragma unroll
                for (int jj = 0; jj < 4; ++jj) { const int sl = st * 16 + quad * 4 + jj; int dist = tl - sl - kb * 128; dist = dist < 0 ? -dist : dist;
                    float v = sc[st][jj] * scale - slope * (float)dist; v = dist <= 128 ? v : -1e30f; sc[st][jj] = v; mx = fmaxf(mx, v); }
            mx = fmaxf(mx, __shfl_xor(mx, 16)); mx = fmaxf(mx, __shfl_xor(mx, 32));
            const float mn = fmaxf(m, mx), alpha = __expf(m - mn); float rs = 0.f;
#pragma unroll
            for (int st = 0; st < 8; ++st)
#pragma unroll
                for (int jj = 0; jj < 4; ++jj) { const float pv = __expf(sc[st][jj] - mn); sc[st][jj] = pv; rs += pv; }
            rs += __shfl_xor(rs, 16); rs += __shfl_xor(rs, 32);
            l = l * alpha + rs; m = mn;
#pragma unroll
            for (int dt = 0; dt < 8; ++dt) oacc[dt] = oacc[dt] * alpha;
#pragma unroll
            for (int st = 0; st < 8; ++st) { u32x2 wv; wv.x = cvt_pk_bf16(sc[st][0], sc[st][1]); wv.y = cvt_pk_bf16(sc[st][2], sc[st][3]);
                *(LAS u32x2*)(Ps + img_off(tl, st * 2 + (quad >> 1), 2048) + (quad & 1) * 8) = wv; }
            asm volatile("s_waitcnt lgkmcnt(0)" ::: "memory");
            const int wh = w >> 1;
#pragma unroll
            for (int k = 0; k < 4; ++k) {
                const bool pv_ok = kb < 0 ? (k >= wh) : (kb > 0 ? (k <= wh) : true);
                if (pv_ok) {
                    const bf16x8 pf = *(const LAS bf16x8*)(Ps + ((k & 1) ? fb1 : fb0) + w * 256 + k * 8192);
                    bf16x8 vf[8];
#pragma unroll
                    for (int dt = 0; dt < 8; ++dt) vf[dt] = *(const LAS bf16x8*)(Vs + ((k & 1) ? fb1 : fb0) + dt * 256 + k * 8192);
                    __builtin_amdgcn_sched_barrier(0);
#pragma unroll
                    for (int dt = 0; dt < 8; ++dt) oacc[dt] = mfma16(vf[dt], pf, oacc[dt]);
                    __builtin_amdgcn_sched_barrier(0);
                }
            }
            if (kb == kb_last) break;
            ++kb;
        }
        { const float inv = 1.0f / l;
          const size_t tok = (size_t)b * SEQ + (size_t)n * 128 + tl;
#pragma unroll
          for (int dt = 0; dt < 8; ++dt) { const int d = dt * 16 + quad * 4;
              const u32x2 zz = *(const u32x2*)(proj0 + tok * N0 + 4352 + hq * 128 + d);
              const float o0 = oacc[dt][0] * inv * siluf_(bf_lo(zz.x)), o1 = oacc[dt][1] * inv * siluf_(bf_hi(zz.x)), o2 = oacc[dt][2] * inv * siluf_(bf_lo(zz.y)), o3 = oacc[dt][3] * inv * siluf_(bf_hi(zz.y));
              u32x2 wv; wv.x = cvt_pk_bf16(o0, o1); wv.y = cvt_pk_bf16(o2, o3);
              *(u32x2*)(mix0 + tok * 2048 + 1024 + hq * 128 + d) = wv; } }
        it = it2; if (it >= 4096) break;
        b = it >> 9; n = (it >> 3) & 63; hq = it & 7; kb = (n == 0) ? 0 : -1;
    }
#undef ATT_LOADKV
#undef ATT_LOADQ
}

__device__ __forceinline__ void sgu_item(LAS unsigned char* lds, const Params& p, int b, int n, int g) {
    const int tid = tid_op(), w = tid >> 6, lane = tid & 63, l15 = lane & 15, quad = lane >> 4;
    const bf16_t* proj0 = (const bf16_t*)(p.ws + OFF_PROJ0); bf16_t* mix0 = (bf16_t*)(p.ws + OFF_MIX0);
    const size_t tok0 = (size_t)b * SEQ + (size_t)n * 128;
    LAS unsigned char* VnT = lds; LAS unsigned char* Ws = lds + 65536;
    u32x2 upre[16], zpre[16];
    { const bf16_t* up = proj0 + (tok0 + w * 16 + l15) * N0 + g * 256 + quad * 4;
#pragma unroll
      for (int ct = 0; ct < 16; ++ct) { upre[ct] = *(const u32x2*)(up + ct * 16); zpre[ct] = *(const u32x2*)(up + 2048 + ct * 16); } }
    __syncthreads();
    { const float* wp = p.w_s + (size_t)g * 16384;
#pragma unroll
      for (int i = 0; i < 8; ++i) { const int idx = tid + i * 512, r = idx >> 5, c4 = idx & 31; const f32x4 v = *(const f32x4*)(wp + r * 128 + c4 * 4);
          u32x2 wv; wv.x = cvt_pk_bf16(v[0], v[1]); wv.y = cvt_pk_bf16(v[2], v[3]); *(LAS u32x2*)(Ws + img_off(r, c4 >> 1, 2048) + (c4 & 1) * 8) = wv; } }
    __syncthreads();
    {
      const int sidx = tid & 127;
      float s_ = 0.f, ss = 0.f;
      { const f32x4* sp = (const f32x4*)((const float*)(p.ws + OFF_STATP) + (tok0 + sidx) * 32);
#pragma unroll
        for (int q = 0; q < 8; ++q) { const f32x4 t4 = sp[q]; s_ += t4[0] + t4[2]; ss += t4[1] + t4[3]; } }
      const float mu = s_ * (1.0f / 1024.0f), rstd = rsqrtf(fmaxf(ss * (1.0f / 1024.0f) - mu * mu, 0.f) + 1e-6f);
#pragma unroll
      for (int i = 0; i < 8; ++i) { const int c8 = (tid >> 7) + i * 4;
          const u32x4 v = *(const u32x4*)(proj0 + (tok0 + sidx) * N0 + 1024 + g * 256 + c8 * 8);
          const f32x4 g0 = *(const f32x4*)(p.ln_g + g * 256 + c8 * 8), g1 = *(const f32x4*)(p.ln_g + g * 256 + c8 * 8 + 4);
          const f32x4 b0 = *(const f32x4*)(p.ln_b + g * 256 + c8 * 8), b1 = *(const f32x4*)(p.ln_b + g * 256 + c8 * 8 + 4);
          float e[8];
#pragma unroll
          for (int j = 0; j < 4; ++j) { e[2 * j] = (bf_lo(v[j]) - mu) * rstd; e[2 * j + 1] = (bf_hi(v[j]) - mu) * rstd; }
#pragma unroll
          for (int j = 0; j < 4; ++j) { e[j] = e[j] * g0[j] + b0[j]; e[4 + j] = e[4 + j] * g1[j] + b1[j]; }
#pragma unroll
          for (int j = 0; j < 8; ++j) *(LAS unsigned short*)(VnT + img_off(c8 * 8 + j, sidx >> 3, 4096) + (sidx & 7) * 2) = (unsigned short)cvt_pk_bf16(e[j], 0.f); } }
    __syncthreads();
    bf16x8 wf[4];
#pragma unroll
    for (int k = 0; k < 4; ++k) wf[k] = *(const LAS bf16x8*)(Ws + FRAG_BASE(2048, k & 1) + w * 256 + k * 8192);
    const int vb0 = FRAG_BASE(4096, 0), vb1 = FRAG_BASE(4096, 1);
    const int t = w * 16 + l15; const size_t tok = tok0 + t; const float bs = p.b_s[g * 128 + t];
#pragma unroll
    for (int cp = 0; cp < 8; ++cp) {
      bf16x8 vf[2][4];
#pragma unroll
      for (int i = 0; i < 2; ++i)
#pragma unroll
          for (int k = 0; k < 4; ++k) vf[i][k] = *(const LAS bf16x8*)(VnT + ((k & 1) ? vb1 : vb0) + (cp * 2 + i) * 256 + k * 16384);
      __builtin_amdgcn_sched_barrier(0);
      f32x4 a2[2] = {(f32x4){0.f, 0.f, 0.f, 0.f}, (f32x4){0.f, 0.f, 0.f, 0.f}};
#pragma unroll
      for (int k = 0; k < 4; ++k) { a2[0] = mfma16(vf[0][k], wf[k], a2[0]); a2[1] = mfma16(vf[1][k], wf[k], a2[1]); }
      __builtin_amdgcn_sched_barrier(0);
#pragma unroll
      for (int i = 0; i < 2; ++i) { const int ct = cp * 2 + i; const f32x4 a = a2[i];
        const int c = g * 256 + ct * 16 + quad * 4;
        const u32x2 uu = upre[ct], zz = zpre[ct];
        const float o0 = bf_lo(uu.x) * (a[0] + bs) * siluf_(bf_lo(zz.x)), o1 = bf_hi(uu.x) * (a[1] + bs) * siluf_(bf_hi(zz.x));
        const float o2 = bf_lo(uu.y) * (a[2] + bs) * siluf_(bf_lo(zz.y)), o3 = bf_hi(uu.y) * (a[3] + bs) * siluf_(bf_hi(zz.y));
        u32x2 wv; wv.x = cvt_pk_bf16(o0, o1); wv.y = cvt_pk_bf16(o2, o3);
        *(u32x2*)(mix0 + tok * 2048 + c) = wv; } }
}

constexpr int SC_KT = 16384, SC_KTT = 32768, SC_IT = 49152, SC_DN = 57344, SC_SET = 57856;
constexpr int SC_AL = 2 * SC_SET, SC_ST = SC_AL + 8192, SC_SEG = SC_ST + 16384, SC_END = SC_SEG + 4096;
__device__ __forceinline__ void scan_item(LAS unsigned char* lds, const Params& p, int item) {
    const int tid = tid_op(), w = tid >> 6, lane = tid & 63, l15 = lane & 15, quad = lane >> 4;
    const int bl = item >> 6, h = (item >> 2) & 15, dir = (item >> 1) & 1, vh = item & 1;
    const bf16_t* proj1 = (const bf16_t*)(p.ws + OFF_PROJ1); const bf16_t* itg = (const bf16_t*)(p.ws + OFF_IT);
    bf16_t* og = (bf16_t*)(p.ws + (dir ? OFF_OB : OFF_OF));
    const int col = h * 128 + 2 * lane;
    LAS unsigned char* Al = lds + SC_AL; LAS unsigned char* ST = lds + SC_ST; LAS float* segp = (LAS float*)(lds + SC_SEG);
    const size_t rowbase = (size_t)bl * SEQ;
    const bf16_t* fbase = proj1 + (rowbase + w * 8) * N1 + col + 2048 + dir * 2048;
    const bf16_t* qbase = proj1 + (rowbase + w * 8) * N1 + col;
    const bf16_t* ibase = itg + (size_t)(h * 128 + vh * 64 + (tid >> 3)) * MH + rowbase + (tid & 7) * 8;
    const bool mma_first = (w & 4) != 0;
    const int tt = w >> 1;
    const int fa0 = FRAG_BASE(1024, 0), fa1 = FRAG_BASE(1024, 1), fk0 = FRAG_BASE(2048, 0), fk1 = FRAG_BASE(2048, 1);
    f32x4 sacc[4];
#pragma unroll
    for (int i = 0; i < 4; ++i) sacc[i] = (f32x4){0.f, 0.f, 0.f, 0.f};
    unsigned fraw[8], qraw[8]; u32x4 iraw;
    f32x2 kv[8], cv[8];
    bf16x8 qf[4];
#define SC_LOAD_F(n_) do { const size_t _ro = (size_t)(n_) * 64 * N1; _Pragma("unroll") for (int j = 0; j < 8; ++j) fraw[j] = *(const unsigned*)(fbase + _ro + (size_t)j * N1); } while (0)
#define SC_LOAD_QI(n_) do { const size_t _ro = (size_t)(n_) * 64 * N1; _Pragma("unroll") for (int j = 0; j < 8; ++j) qraw[j] = *(const unsigned*)(qbase + _ro + (size_t)j * N1); \
        iraw = *(const u32x4*)(ibase + (size_t)(n_) * 64); } while (0)
#define SC_LOAD(n_) do { SC_LOAD_F(n_); SC_LOAD_QI(n_); } while (0)
#define SC_GATE_A() do { _Pragma("unroll") for (int j = 0; j < 8; ++j) { cv[j] = (f32x2){bf_lo(fraw[j]), bf_hi(fraw[j])}; kv[j] = 1.0f - cv[j]; } \
        if (!dir) { _Pragma("unroll") for (int j = 1; j < 8; ++j) cv[j] = cv[j] * cv[j - 1]; } else { _Pragma("unroll") for (int j = 6; j >= 0; --j) cv[j] = cv[j] * cv[j + 1]; } \
        *(LAS f32x2*)(segp + w * 128 + 2 * lane) = dir ? cv[0] : cv[7]; } while (0)
#define SC_GATE_B(SET_) do { LAS unsigned char* _set = lds + (SET_) * SC_SET; f32x2 off = (f32x2){1.f, 1.f}, tot = (f32x2){1.f, 1.f}; \
        _Pragma("unroll") for (int w2 = 0; w2 < 8; ++w2) { const f32x2 tv = *(const LAS f32x2*)(segp + w2 * 128 + 2 * lane); tot = tot * tv; const bool before = dir ? (w2 > w) : (w2 < w); off = off * (before ? tv : (f32x2){1.f, 1.f}); } \
        f32x2 kt[8]; \
        _Pragma("unroll") for (int j = 0; j < 8; ++j) { const f32x2 P = off * cv[j]; const f32x2 ip = (f32x2){__builtin_amdgcn_rcpf(P[0]), __builtin_amdgcn_rcpf(P[1])}; kt[j] = kv[j] * ip; \
            const f32x2 qt = (f32x2){bf_lo(qraw[j]), bf_hi(qraw[j])} * P; \
            *(LAS unsigned*)(_set + img_off(w * 8 + j, lane >> 2, 1024) + (lane & 3) * 4) = cvt_pk_bf16(qt[0], qt[1]); \
            *(LAS unsigned*)(_set + SC_KT + img_off(w * 8 + j, lane >> 2, 1024) + (lane & 3) * 4) = cvt_pk_bf16(kt[j][0], kt[j][1]); } \
        { u32x4 e; e.x = cvt_pk_bf16(kt[0][0], kt[1][0]); e.y = cvt_pk_bf16(kt[2][0], kt[3][0]); e.z = cvt_pk_bf16(kt[4][0], kt[5][0]); e.w = cvt_pk_bf16(kt[6][0], kt[7][0]); \
          *(LAS u32x4*)(_set + SC_KTT + img_off(2 * lane, w, 2048)) = e; \
          e.x = cvt_pk_bf16(kt[0][1], kt[1][1]); e.y = cvt_pk_bf16(kt[2][1], kt[3][1]); e.z = cvt_pk_bf16(kt[4][1], kt[5][1]); e.w = cvt_pk_bf16(kt[6][1], kt[7][1]); \
          *(LAS u32x4*)(_set + SC_KTT + img_off(2 * lane + 1, w, 2048)) = e; } \
        if (w == 0) *(LAS f32x2*)(_set + SC_DN + lane * 8) = tot; \
        *(LAS u32x4*)(_set + SC_IT + img_off(tid >> 3, tid & 7, 1024)) = iraw; } while (0)
#define SC_MMA1(SET_) do { const LAS unsigned char* _set = lds + (SET_) * SC_SET; bf16x8 kf[2][4]; \
        _Pragma("unroll") for (int k = 0; k < 4; ++k) qf[k] = *(const LAS bf16x8*)(_set + ((k & 1) ? fa1 : fa0) + tt * 256 + k * 4096); \
        _Pragma("unroll") for (int i = 0; i < 2; ++i) _Pragma("unroll") for (int k = 0; k < 4; ++k) kf[i][k] = *(const LAS bf16x8*)(_set + SC_KT + ((k & 1) ? fa1 : fa0) + ((w & 1) * 2 + i) * 256 + k * 4096); \
        __builtin_amdgcn_sched_barrier(0); \
        f32x4 a0 = (f32x4){0.f, 0.f, 0.f, 0.f}, a1 = (f32x4){0.f, 0.f, 0.f, 0.f}; \
        _Pragma("unroll") for (int k = 0; k < 4; ++k) { a0 = mfma16(kf[0][k], qf[k], a0); a1 = mfma16(kf[1][k], qf[k], a1); } \
        __builtin_amdgcn_sched_barrier(0); \
        const int t = tt * 16 + l15; \
        _Pragma("unroll") for (int i = 0; i < 2; ++i) { const int st = (w & 1) * 2 + i; f32x4 a = i ? a1 : a0; \
            _Pragma("unroll") for (int jj = 0; jj < 4; ++jj) { const int s_ = st * 16 + quad * 4 + jj; const bool ok = dir ? (s_ >= t) : (s_ <= t); a[jj] = ok ? a[jj] : 0.f; } \
            u32x2 wv; wv.x = cvt_pk_bf16(a[0], a[1]); wv.y = cvt_pk_bf16(a[2], a[3]); \
            *(LAS u32x2*)(Al + img_off(t, st * 2 + (quad >> 1), 1024) + (quad & 1) * 8) = wv; } } while (0)
#define SC_MMA2(SET_, n_) do { const LAS unsigned char* _set = lds + (SET_) * SC_SET; \
        bf16x8 vf[4][2]; \
        { bf16x8 af[2], sf[2][4]; \
          _Pragma("unroll") for (int k = 0; k < 2; ++k) af[k] = *(const LAS bf16x8*)(Al + ((k & 1) ? fa1 : fa0) + tt * 256 + k * 4096); \
          _Pragma("unroll") for (int vt = 0; vt < 4; ++vt) _Pragma("unroll") for (int k = 0; k < 2; ++k) vf[vt][k] = *(const LAS bf16x8*)(_set + SC_IT + ((k & 1) ? fa1 : fa0) + vt * 256 + k * 4096); \
          _Pragma("unroll") for (int i = 0; i < 2; ++i) _Pragma("unroll") for (int k = 0; k < 4; ++k) sf[i][k] = *(const LAS bf16x8*)(ST + ((k & 1) ? fa1 : fa0) + ((w & 1) * 2 + i) * 256 + k * 4096); \
          __builtin_amdgcn_sched_barrier(0); \
          f32x4 o0 = (f32x4){0.f, 0.f, 0.f, 0.f}, o1 = (f32x4){0.f, 0.f, 0.f, 0.f}, p0 = (f32x4){0.f, 0.f, 0.f, 0.f}, p1 = (f32x4){0.f, 0.f, 0.f, 0.f}; \
          _Pragma("unroll") for (int k = 0; k < 2; ++k) { if (w & 1) { p0 = mfma16(vf[2][k], af[k], p0); p1 = mfma16(vf[3][k], af[k], p1); } else { p0 = mfma16(vf[0][k], af[k], p0); p1 = mfma16(vf[1][k], af[k], p1); } } \
          _Pragma("unroll") for (int k = 0; k < 4; ++k) { o0 = mfma16(sf[0][k], qf[k], o0); o1 = mfma16(sf[1][k], qf[k], o1); } \
          __builtin_amdgcn_sched_barrier(0); \
          o0 = o0 + p0; o1 = o1 + p1; \
          const size_t r = rowbase + (size_t)(n_) * 64 + tt * 16 + l15; \
          u32x2 wv; wv.x = cvt_pk_bf16(o0[0], o0[1]); wv.y = cvt_pk_bf16(o0[2], o0[3]); \
          *(u32x2*)(og + r * 2048 + h * 128 + vh * 64 + ((w & 1) * 2) * 16 + quad * 4) = wv; \
          wv.x = cvt_pk_bf16(o1[0], o1[1]); wv.y = cvt_pk_bf16(o1[2], o1[3]); \
          *(u32x2*)(og + r * 2048 + h * 128 + vh * 64 + ((w & 1) * 2 + 1) * 16 + quad * 4) = wv; } \
        { const f32x4 dv = *(const LAS f32x4*)(_set + SC_DN + (w * 16 + quad * 4) * 4); \
          bf16x8 ktf[2]; \
          _Pragma("unroll") for (int k = 0; k < 2; ++k) ktf[k] = *(const LAS bf16x8*)(_set + SC_KTT + ((k & 1) ? fk1 : fk0) + w * 256 + k * 8192); \
          __builtin_amdgcn_sched_barrier(0); \
          _Pragma("unroll") for (int k = 0; k < 2; ++k) _Pragma("unroll") for (int vt = 0; vt < 4; ++vt) sacc[vt] = mfma16(ktf[k], vf[vt][k], sacc[vt]); \
          __builtin_amdgcn_sched_barrier(0); \
          _Pragma("unroll") for (int vt = 0; vt < 4; ++vt) sacc[vt] = sacc[vt] * dv; } } while (0)
#define SC_ST_WRITE() do { _Pragma("unroll") for (int vt = 0; vt < 4; ++vt) { u32x2 wv; wv.x = cvt_pk_bf16(sacc[vt][0], sacc[vt][1]); wv.y = cvt_pk_bf16(sacc[vt][2], sacc[vt][3]); \
        *(LAS u32x2*)(ST + img_off(vt * 16 + l15, w * 2 + (quad >> 1), 1024) + (quad & 1) * 8) = wv; } } while (0)

    __syncthreads();
    SC_LOAD(dir ? 127 : 0);
    SC_GATE_A();
    __syncthreads();
    SC_GATE_B(0);
    SC_LOAD(dir ? 126 : 1);
    __syncthreads();
#pragma unroll 2
    for (int c = 0; c < 128; ++c) {
        const int n = dir ? 127 - c : c, cur = c & 1;
        SC_ST_WRITE();
        if (mma_first) { SC_MMA1(cur); if (c + 1 < 128) SC_GATE_A(); } else { if (c + 1 < 128) SC_GATE_A(); SC_MMA1(cur); }
        __syncthreads();
        if (c + 2 < 128) SC_LOAD_F(dir ? 125 - c : c + 2);
        if (mma_first) { SC_MMA2(cur, n); if (c + 1 < 128) { SC_GATE_B(cur ^ 1); if (c + 2 < 128) SC_LOAD_QI(dir ? 125 - c : c + 2); } }
        else { if (c + 1 < 128) { SC_GATE_B(cur ^ 1); if (c + 2 < 128) SC_LOAD_QI(dir ? 125 - c : c + 2); } SC_MMA2(cur, n); }
        __syncthreads();
    }
#undef SC_LOAD
#undef SC_LOAD_F
#undef SC_LOAD_QI
#undef SC_GATE_A
#undef SC_GATE_B
#undef SC_MMA1
#undef SC_MMA2
#undef SC_ST_WRITE
}

__device__ __forceinline__ void gate_phase(const Params& p) {
    const int tid = tid_op(), sub = tid & 15, grp = tid >> 4;
    bf16_t* of = (bf16_t*)(p.ws + OFF_OF); const bf16_t* ob = (const bf16_t*)(p.ws + OFF_OB); const bf16_t* proj1 = (const bf16_t*)(p.ws + OFF_PROJ1);
    const int h = grp & 15, col = h * 128 + sub * 8;
    const f32x4 g0 = *(const f32x4*)(p.head_g + col), g1 = *(const f32x4*)(p.head_g + col + 4);
    for (int it0 = blockIdx.x * 4; it0 < MH / 2; it0 += gridDim.x * 4) {
        u32x4 a[4], b[4], z[4];
#pragma unroll
        for (int q = 0; q < 4; ++q) { const size_t tokl = (size_t)(it0 + q) * 2 + (grp >> 4);
            a[q] = __builtin_nontemporal_load((const u32x4*)(of + tokl * 2048 + col)); b[q] = __builtin_nontemporal_load((const u32x4*)(ob + tokl * 2048 + col)); z[q] = __builtin_nontemporal_load((const u32x4*)(proj1 + tokl * N1 + 6144 + col)); }
#pragma unroll
        for (int q = 0; q < 4; ++q) { const size_t tokl = (size_t)(it0 + q) * 2 + (grp >> 4);
            float o[8]; float ss = 0.f;
#pragma unroll
            for (int j = 0; j < 4; ++j) { o[2 * j] = bf_lo(a[q][j]) + bf_lo(b[q][j]); o[2 * j + 1] = bf_hi(a[q][j]) + bf_hi(b[q][j]); ss += o[2 * j] * o[2 * j] + o[2 * j + 1] * o[2 * j + 1]; }
            ss += __shfl_xor(ss, 1); ss += __shfl_xor(ss, 2); ss += __shfl_xor(ss, 4); ss += __shfl_xor(ss, 8);
            const float rs = rsqrtf(ss * (1.0f / 128.0f) + 1e-6f);
            u32x4 wv;
#pragma unroll
            for (int j = 0; j < 4; ++j) { const float gl = j < 2 ? g0[2 * j] : g1[2 * j - 4], gh = j < 2 ? g0[2 * j + 1] : g1[2 * j - 3];
                wv[j] = cvt_pk_bf16(o[2 * j] * rs * gl * siluf_(bf_lo(z[q][j])), o[2 * j + 1] * rs * gh * siluf_(bf_hi(z[q][j]))); }
            *(u32x4*)(of + tokl * 2048 + col) = wv; }
    }
}

__device__ __forceinline__ void run_gemm(LAS unsigned char* lds, const bf16_t* A, const bf16_t* Bt, int M, int N, int K, const pg8::Epi& E) {
    pg8::Gemm g; g.A = A; g.Bt = Bt; g.M = M; g.N = N; g.K = K;
    pg8::StaticOrder S; S.init(M, N, (int)gridDim.x, (int)blockIdx.x);
    pg8::gemm_phase(lds, g, S, E);
}

__device__ __forceinline__ void grid_bar(unsigned* ctr, unsigned target) {
    __syncthreads();
    if (threadIdx.x == 0) {
        __builtin_amdgcn_fence(__ATOMIC_RELEASE, "agent");
        const unsigned g = blockIdx.x & 7u, gsz = (gridDim.x - g + 7u) >> 3;
        const unsigned old = __hip_atomic_fetch_add(ctr + 16 + 16 * g, 1u, __ATOMIC_RELAXED, __HIP_MEMORY_SCOPE_AGENT);
        if ((old + 1u) % gsz == 0u) __hip_atomic_fetch_add(ctr, gsz, __ATOMIC_RELAXED, __HIP_MEMORY_SCOPE_AGENT);
        while (__hip_atomic_load(ctr, __ATOMIC_RELAXED, __HIP_MEMORY_SCOPE_AGENT) < target) __builtin_amdgcn_s_sleep(3);
        __builtin_amdgcn_fence(__ATOMIC_ACQUIRE, "agent");
    }
    __syncthreads();
}
__device__ __forceinline__ void grid_arrive(unsigned* ctr) {
    __syncthreads();
    if (threadIdx.x == 0) { __threadfence(); __hip_atomic_fetch_add(ctr, 1u, __ATOMIC_RELAXED, __HIP_MEMORY_SCOPE_AGENT); }
}
__device__ __forceinline__ void grid_wait(unsigned* ctr, unsigned target) {
    if (threadIdx.x == 0) { while (__hip_atomic_load(ctr, __ATOMIC_RELAXED, __HIP_MEMORY_SCOPE_AGENT) < target) __builtin_amdgcn_s_sleep(1); __threadfence(); }
    __syncthreads();
}
__device__ __forceinline__ void sgu_stats(const Params& p) {
    const int tid = tid_op(), lane = tid & 63, wv = tid >> 6;
    const bf16_t* proj0 = (const bf16_t*)(p.ws + OFF_PROJ0); float* stat = (float*)(p.ws + OFF_STAT);
    for (int r0 = (blockIdx.x * 8 + wv) * 4; r0 < MTOK; r0 += gridDim.x * 32) {
        u32x4 a[4], b[4];
#pragma unroll
        for (int q = 0; q < 4; ++q) { a[q] = *(const u32x4*)(proj0 + (size_t)(r0 + q) * N0 + 1024 + lane * 8); b[q] = *(const u32x4*)(proj0 + (size_t)(r0 + q) * N0 + 1536 + lane * 8); }
#pragma unroll
        for (int q = 0; q < 4; ++q) {
            float s_ = 0.f, ss = 0.f;
#pragma unroll
            for (int j = 0; j < 4; ++j) { const float x0 = bf_lo(a[q][j]), x1 = bf_hi(a[q][j]), x2 = bf_lo(b[q][j]), x3 = bf_hi(b[q][j]); s_ += (x0 + x1) + (x2 + x3); ss += (x0 * x0 + x1 * x1) + (x2 * x2 + x3 * x3); }
#pragma unroll
            for (int o = 32; o >= 1; o >>= 1) { s_ += __shfl_xor(s_, o); ss += __shfl_xor(ss, o); }
            const float mu = s_ * (1.0f / 1024.0f), var = fmaxf(ss * (1.0f / 1024.0f) - mu * mu, 0.f);
            if (lane == 0) *(f32x2*)(stat + (size_t)(r0 + q) * 2) = (f32x2){mu, rsqrtf(var + 1e-6f)};
        }
    }
}
__global__ void __launch_bounds__(512, 2) mega(Params p) {
    extern __shared__ __attribute__((aligned(16))) unsigned char shm[];
    LAS unsigned char* lds = (LAS unsigned char*)shm;
    cg::grid_group grid = cg::this_grid();
    unsigned char* ws = p.ws;
    int nbar = 0;
#if PROBE_SYNCS
    for (int i = 0; i < PROBE_SYNCS; ++i) grid.sync();
#endif
    for (int ph2 = p.ph_lo * 2; ph2 < p.ph_hi * 2; ++ph2) {
        const int ph = ph2 >> 1;
        if ((ph2 & 1) && !((REPEAT_MASK >> ph) & 1)) continue;
        if (ph == 9) continue;
        if (ph2 > p.ph_lo * 2) {
            if (nbar == 0) grid.sync();
            else grid_bar((unsigned*)(ws + OFF_BAR), (unsigned)nbar * gridDim.x);
            ++nbar;
        }
        const int hb = ph >= 9 ? 1 : 0;
        const bool is_gemm = (ph == 1 || ph == 3 || ph == 5 || ph == 8 || ph == 9 || ph == 12);
        if (is_gemm) {
            const int ng = (ph == 8) ? 3 : (ph == 1 || ph == 5) ? 2 : 1;
            for (int gj = 0; gj < ng; ++gj) {
                const int gi = (ph == 8) ? gj - 1 : gj;
                const bf16_t* A; const bf16_t* Bt; int M, N, K; pg8::Epi E; E.mode = 0; E.O = nullptr; E.ldo = 0; E.silu_cols = 0; E.C = nullptr; E.R = nullptr; E.ldc = 0; E.lbv = nullptr; E.f_lo = 0; E.f_hi = 0; E.statp = nullptr; E.s_lo = 0; E.s_hi = 0;
                if (ph == 1) {
                    K = 1024;
                    if (gi == 0) { A = (const bf16_t*)(ws + OFF_H0); Bt = (const bf16_t*)(ws + OFF_WT0); M = MTOK; N = N0; E.O = (bf16_t*)(ws + OFF_PROJ0); E.ldo = N0; E.statp = (float*)(ws + OFF_STATP); E.s_lo = 1024; E.s_hi = 2048; }
                    else { A = (const bf16_t*)(ws + OFF_WT0) + (size_t)N0 * 1024; Bt = (const bf16_t*)(ws + OFF_H0); M = 256; N = MTOK; E.O = (bf16_t*)(ws + OFF_VBT); E.ldo = MTOK; }
                } else if (ph == 3) {
                    K = 2048; A = (const bf16_t*)(ws + OFF_MIX0); Bt = (const bf16_t*)(ws + OFF_WT0O); M = MTOK; N = 1024; E.mode = 1; E.C = p.out; E.R = p.x; E.ldc = 1024;
                } else if (ph == 5 || (ph == 8 && gj > 0)) {
                    K = 1024;
                    if (gi == 0) { A = (const bf16_t*)(ws + OFF_H1); Bt = (const bf16_t*)(ws + OFF_WT1); M = MH; N = N1; E.O = (bf16_t*)(ws + OFF_PROJ1); E.ldo = N1; E.silu_cols = 2048; E.lbv = (const float*)(ws + OFF_LB); E.f_lo = 2048; E.f_hi = 6144; }
                    else { A = (const bf16_t*)(ws + OFF_WT1) + (size_t)N1 * 1024; Bt = (const bf16_t*)(ws + OFF_H1); M = 2048; N = MH; E.O = (bf16_t*)(ws + OFF_IT); E.ldo = MH; }
                } else {
                    K = 2048; A = (const bf16_t*)(ws + OFF_OF); Bt = (const bf16_t*)(ws + OFF_WT1O); M = MH; N = 1024; E.mode = 1;
                    float* o = p.out + (size_t)(ph == 12 ? 1 : 0) * MH * 1024; E.C = o; E.R = o; E.ldc = 1024;
                }
#ifndef NO_GEMM
                run_gemm(lds, A, Bt, M, N, K, E);
#endif
            }
        } else if (ph == 0) {
            { float* lbt = (float*)(ws + OFF_LB);
              for (int i = blockIdx.x * 512 + tid_op(); i < 4096; i += gridDim.x * 512) { const float* gm = i < 2048 ? p.gamma_f : p.gamma_b; const int cc = i & 2047; lbt[i] = sigmoidf_(gm[2048 + cc] - gm[cc]); } }
            prep_weights(lds, p);
            rms_rows_bf16(p.x, p.norm_g_even, (bf16_t*)(ws + OFF_H0), MTOK);
        } else if (ph == 2) {
#ifndef NO_ATT
            att_phase(lds, p);
#endif
#ifndef NO_SGU
            for (int j = blockIdx.x; j < 2048; j += gridDim.x) sgu_item(lds, p, j >> 8, (j >> 2) & 63, j & 3);
#endif
        } else if (ph == 4) {
            rms_rows_bf16(p.out, p.norm_g_odd, (bf16_t*)(ws + OFF_H1), MH);
        } else if (ph == 6 || ph == 10) {
            Params q = p; q.ws = ws;
#ifndef NO_SCAN
            for (int it = blockIdx.x; it < 256; it += gridDim.x) {
                const int item = (gridDim.x == 256) ? (((it & 7) * 8 + (it >> 5)) * 4 + ((it >> 3) & 3)) : it;
                scan_item(lds, q, item); }
#endif
        } else if (ph == 7 || ph == 11) {
            gate_phase(p);
            if (ph == 7) rms_rows_bf16(p.out + (size_t)MH * 1024, p.norm_g_odd, (bf16_t*)(ws + OFF_H1), MH);
        } else if (ph == 13) {
            rms_rows_f32_inplace(p.out, p.final_g, MTOK);
        }
        (void)hb;
    }
}

extern "C" void kernel_launch(void* const* d_in, const int* in_sizes, int n_in, void* d_out, int out_size, void* d_ws, size_t ws_size, hipStream_t stream) {
    static int grid = 0;
    if (grid == 0) {
        if (n_in != 16 || out_size != MTOK * DM || ws_size < WS_NEED) { fprintf(stderr, "kernel_launch: unexpected shapes (n_in %d out %d ws %zu)\n", n_in, out_size, ws_size); grid = -1; return; }
        int dev = 0, cus = 0, per_cu = 0;
        hipGetDevice(&dev); hipDeviceGetAttribute(&cus, hipDeviceAttributeMultiprocessorCount, dev);
        hipFuncSetAttribute((const void*)mega, hipFuncAttributeMaxDynamicSharedMemorySize, LDS_BYTES);
        hipOccupancyMaxActiveBlocksPerMultiprocessor(&per_cu, (const void*)mega, 512, LDS_BYTES);
        if (per_cu < 1) per_cu = 1;
        grid = cus * per_cu;
        (void)hipGetLastError();
    }
    if (grid < 0) return;
    hipMemsetAsync((unsigned char*)d_ws + OFF_BAR, 0, 1024, stream);
    Params p{};
    p.x = (const float*)d_in[0]; p.norm_g_even = (const float*)d_in[1]; p.w_in_even = (const float*)d_in[2]; p.ln_g = (const float*)d_in[3]; p.ln_b = (const float*)d_in[4];
    p.w_s = (const float*)d_in[5]; p.b_s = (const float*)d_in[6]; p.sink = (const float*)d_in[7]; p.w_out_even = (const float*)d_in[8]; p.norm_g_odd = (const float*)d_in[9];
    p.w_in_odd = (const float*)d_in[10]; p.gamma_f = (const float*)d_in[11]; p.gamma_b = (const float*)d_in[12]; p.head_g = (const float*)d_in[13]; p.w_out_odd = (const float*)d_in[14];
    p.final_g = (const float*)d_in[15]; p.out = (float*)d_out; p.ws = (unsigned char*)d_ws;
#if N_LAUNCH_MODE == 1
    p.ph_lo = 0; p.ph_hi = NPHASE;
    void* args[] = {&p};
    hipError_t e = hipLaunchCooperativeKernel((const void*)mega, dim3(grid), dim3(512), args, LDS_BYTES, stream);
    if (e != hipSuccess) fprintf(stderr, "cooperative launch failed: %s (grid %d)\n", hipGetErrorString(e), grid);
#else
    for (int ph = 0; ph < NPHASE; ++ph) { if (PH_SKIP(ph)) continue; p.ph_lo = ph; p.ph_hi = ph + 1; hipLaunchKernelGGL(mega, dim3(grid), dim3(512), LDS_BYTES, stream, p); }
#endif
}
```

```cpp
#include <hip/hip_runtime.h>
#include <hip/hip_cooperative_groups.h>
#include <cstdio>
namespace cg = cooperative_groups;

#ifndef N_LAUNCH_MODE
#define N_LAUNCH_MODE 1
#endif

#ifndef PROBE_ATT2
#define PROBE_ATT2 0
#endif
#ifndef PROBE_SYNCS
#define PROBE_SYNCS 0
#endif
#ifndef REPEAT_MASK
#define REPEAT_MASK 0
#endif
#ifndef PH_SKIP
#define PH_SKIP(ph) 0
#define EXP_NOSCAN 0
#endif
#ifndef GEMM_SP2
#define GEMM_SP2 1
#endif
#define LAS __attribute__((address_space(3)))
typedef unsigned short bf16_t;
typedef short bf16x8 __attribute__((ext_vector_type(8)));
typedef float f32x4 __attribute__((ext_vector_type(4)));
typedef float f32x2 __attribute__((ext_vector_type(2)));
typedef unsigned u32x4 __attribute__((ext_vector_type(4)));
typedef unsigned u32x2 __attribute__((ext_vector_type(2)));

constexpr int MTOK = 65536, DM = 1024, SEQ = 8192, MH = 32768;
constexpr int N0 = 5376;
constexpr int N1 = 8192;
constexpr size_t MiB = 1048576;
constexpr size_t OFF_WT0 = 0;
constexpr size_t OFF_WT0O = OFF_WT0 + (size_t)5632 * 1024 * 2;
constexpr size_t OFF_WT1 = OFF_WT0O + (size_t)1024 * 2048 * 2;
constexpr size_t OFF_WT1O = OFF_WT1 + (size_t)10240 * 1024 * 2;
constexpr size_t OFF_LB = 39 * MiB;
constexpr size_t OFF_BAR = 39 * MiB + 65536;
constexpr size_t OFF_STAT = 39 * MiB + 131072;
constexpr size_t OFF_PROJ0 = 40 * MiB;
constexpr size_t OFF_VBT = 712 * MiB;
constexpr size_t OFF_H0 = 744 * MiB;
constexpr size_t OFF_MIX0 = 744 * MiB;
constexpr size_t OFF_H1 = 40 * MiB;
constexpr size_t OFF_PROJ1 = 104 * MiB;
constexpr size_t OFF_IT = 616 * MiB;
constexpr size_t OFF_OF = 744 * MiB;
constexpr size_t OFF_OB = 872 * MiB;
constexpr size_t OFF_STATP = 1000 * MiB;
constexpr size_t WS_NEED = 1008 * MiB;
constexpr int LDS_BYTES = 156672;
constexpr int NPHASE = 14;

struct Params {
    const float* x; const float* norm_g_even; const float* w_in_even; const float* ln_g; const float* ln_b; const float* w_s; const float* b_s; const float* sink; const float* w_out_even;
    const float* norm_g_odd; const float* w_in_odd; const float* gamma_f; const float* gamma_b; const float* head_g; const float* w_out_odd; const float* final_g;
    float* out; unsigned char* ws; int ph_lo, ph_hi;
};

typedef __bf16 bf16x2_t __attribute__((ext_vector_type(2)));
__device__ __forceinline__ unsigned cvt_pk_bf16(float lo, float hi) { f32x2 v = {lo, hi}; bf16x2_t b = __builtin_convertvector(v, bf16x2_t); return __builtin_bit_cast(unsigned, b); }
__device__ __forceinline__ float bf_lo(unsigned w) { return __uint_as_float(w << 16); }
__device__ __forceinline__ float bf_hi(unsigned w) { return __uint_as_float(w & 0xffff0000u); }
__device__ __forceinline__ float sigmoidf_(float x) { return __builtin_amdgcn_rcpf(1.0f + __expf(-x)); }
__device__ __forceinline__ float siluf_(float x) { return x * sigmoidf_(x); }
__device__ __forceinline__ int tid_op() { int t = threadIdx.x; asm volatile("" : "+v"(t)); return t; }
__device__ __forceinline__ int bid_op() { int b = blockIdx.x; asm volatile("" : "+s"(b)); return b; }
__device__ __forceinline__ int img_off(int row, int chunk, int sub) { return chunk * sub + ((row ^ (chunk & 7)) << 4); }
#define FRAG_BASE(sub, par) (quad * (sub) + ((l15 ^ (quad + 4 * (par))) << 4))
__device__ __forceinline__ void store16_stream(void* p, u32x4 v) { asm volatile("global_store_dwordx4 %0, %1, off sc1 nt\n\ts_nop 1" :: "v"(p), "v"(v) : "memory"); }
__device__ __forceinline__ f32x4 mfma16(bf16x8 a, bf16x8 b, f32x4 c) { return __builtin_amdgcn_mfma_f32_16x16x32_bf16(a, b, c, 0, 0, 0); }

namespace pg8 {
constexpr int BM = 256, BK = 64, HALF = 128, HTB = HALF * BK * 2, STAGE_BYTES = 8 * HTB, NXCD = 8, WGM = 4;
__device__ __forceinline__ int lds_byte(int r, int c) { const int st = (r >> 4) * 2 + (c >> 5), rr = r & 15, cc = c & 31, ob = rr * 64 + cc * 2; return st * 1024 + (ob ^ (((ob >> 9) & 1) << 5)); }
__device__ __forceinline__ void stage_rc(int b, int& R, int& C) { const int st = b / 1024, sb = b % 1024, swz = sb ^ (((sb >> 9) & 1) << 5); R = (st >> 1) * 16 + swz / 64; C = (st & 1) * 32 + (swz % 64) / 2; }
__device__ __forceinline__ int perm32(int rho) { const int n = rho >> 4, i = rho & 15; return 8 * (i >> 2) + 4 * n + (i & 3); }
struct Unit { int pm, pn; };
struct Gemm { const bf16_t* A; const bf16_t* Bt; int M, N, K; };
struct StaticOrder {
    int nM, nN, nwg, G, c;
    __device__ void init(int M, int N, int G_, int c_) { nM = M / BM; nN = N / BM; nwg = nM * nN; G = G_; c = c_; }
    __device__ bool next(int i, Unit& u) const {
        const long L = (long)i * G + c; if (L >= nwg) return false;
        int wgid = (int)L; { const int q = nwg / NXCD, r = nwg % NXCD, xcd = wgid % NXCD, off = wgid / NXCD; wgid = (xcd < r ? xcd * (q + 1) : r * (q + 1) + (xcd - r) * q) + off; }
        const int nig = WGM * nN, gid = wgid / nig, fm = gid * WGM, gsz = (nM - fm) < WGM ? (nM - fm) : WGM;
        u.pm = fm + ((wgid % nig) % gsz); u.pn = (wgid % nig) / gsz; return true;
    }
};
struct Epi {
    int mode;
    bf16_t* O; int ldo; int silu_cols;
    const float* lbv; int f_lo, f_hi;
    float* statp; int s_lo, s_hi;
    float* C; const float* R; int ldc;
    __device__ __forceinline__ void operator()(const f32x4 (&acc)[2][2][4][2], const Unit& u, int wr, int wc, int fr, int fq) const {
        const int row0 = u.pm * BM + wr * 64 + fr, col0 = u.pn * BM + wc * 32 + 8 * fq;
        if (mode == 0) {
            const bool act = (u.pn * BM) < silu_cols, isf = (u.pn * BM) >= f_lo && (u.pn * BM) < f_hi, dostat = (u.pn * BM) >= s_lo && (u.pn * BM) < s_hi;
#pragma unroll
            for (int ai = 0; ai < 2; ++ai)
#pragma unroll
                for (int m = 0; m < 4; ++m) { bf16_t* rowp = O + (size_t)(row0 + ai * HALF + m * 16) * ldo + col0;
#pragma unroll
                    for (int bj = 0; bj < 2; ++bj) { f32x4 v0 = acc[ai][bj][m][0], v1 = acc[ai][bj][m][1];
                        if (act) {
#pragma unroll
                            for (int j = 0; j < 4; ++j) { v0[j] = siluf_(v0[j]); v1[j] = siluf_(v1[j]); } }
                        if (isf) { const f32x4 l0 = *(const f32x4*)(lbv + col0 + bj * HALF - f_lo), l1 = *(const f32x4*)(lbv + col0 + bj * HALF - f_lo + 4);
#pragma unroll
                            for (int j = 0; j < 4; ++j) { v0[j] = l0[j] + (1.0f - l0[j]) * sigmoidf_(v0[j]); v1[j] = l1[j] + (1.0f - l1[j]) * sigmoidf_(v1[j]); } }
                        u32x4 w; w.x = cvt_pk_bf16(v0[0], v0[1]); w.y = cvt_pk_bf16(v0[2], v0[3]); w.z = cvt_pk_bf16(v1[0], v1[1]); w.w = cvt_pk_bf16(v1[2], v1[3]);
                        store16_stream(rowp + bj * HALF, w); }
                    if (dostat) {
                        float s_ = 0.f, ss = 0.f;
#pragma unroll
                        for (int bj = 0; bj < 2; ++bj)
#pragma unroll
                            for (int n = 0; n < 2; ++n)
#pragma unroll
                                for (int j = 0; j < 4; ++j) { const float x = acc[ai][bj][m][n][j]; s_ += x; ss += x * x; }
                        s_ += __shfl_xor(s_, 16); ss += __shfl_xor(ss, 16); s_ += __shfl_xor(s_, 32); ss += __shfl_xor(ss, 32);
                        if (fq == 0) *(f32x2*)(statp + ((size_t)(row0 + ai * HALF + m * 16) * 16 + ((u.pn * BM - s_lo) >> 8) * 4 + wc) * 2) = (f32x2){s_, ss}; } }
        } else {
#pragma unroll
            for (int ai = 0; ai < 2; ++ai)
#pragma unroll
                for (int m = 0; m < 4; ++m) { const size_t o = (size_t)(row0 + ai * HALF + m * 16) * ldc + col0;
#pragma unroll
                    for (int bj = 0; bj < 2; ++bj) {
                        const f32x4 r0 = *(const f32x4*)(R + o + bj * HALF), r1 = *(const f32x4*)(R + o + bj * HALF + 4);
                        *(f32x4*)(C + o + bj * HALF) = r0 + acc[ai][bj][m][0]; *(f32x4*)(C + o + bj * HALF + 4) = r1 + acc[ai][bj][m][1]; } }
        }
    }
};

__device__ __forceinline__ void gemm_phase(LAS unsigned char* lds, const Gemm g, const StaticOrder& S, const Epi& E) {
    const int tid = tid_op(), wid = __builtin_amdgcn_readfirstlane(tid >> 6), lane = tid & 63, wr = wid >> 2, wc = wid & 3, fr = lane & 15, fq = lane >> 4;
    const int K = g.K, nt = K / BK;
    unsigned voffA[2], voffB[2];
#pragma unroll
    for (int i = 0; i < 2; ++i) { int R, C; stage_rc(tid * 16 + i * 8192, R, C); const int Rb = (R & ~31) + perm32(R & 31);
        voffA[i] = (unsigned)(R * K + C) * 2u; voffB[i] = (unsigned)(Rb * K + C) * 2u; }
    const size_t kstep = (size_t)(BK * 2);
    const size_t hstep = (size_t)HALF * K * 2;
    const size_t tstep = 2 * hstep;
    const unsigned ldsw = (unsigned)wid * 1024u;
    const int aoff = lds_byte(wr * 64 + fr, fq * 8), boff = lds_byte(wc * 32 + fr, fq * 8);
#define PG8_SA(b, h) (((b) * 2 + (h)) * HTB)
#define PG8_SB(b, h) ((4 + (b) * 2 + (h)) * HTB)
#define PG8_STAGE(bufoff, gbase, voff) do { _Pragma("unroll") for (int _i = 0; _i < 2; ++_i) \
        __builtin_amdgcn_global_load_lds((const unsigned*)((const char*)(gbase) + (voff)[_i]), (LAS unsigned*)(lds + (bufoff) + ldsw + _i * 8192), 16, 0, 0); } while (0)
#define PG8_LDA(dst, b, h) do { _Pragma("unroll") for (int m = 0; m < 4; ++m) _Pragma("unroll") for (int k = 0; k < 2; ++k) dst[m][k] = *(const LAS bf16x8*)(lds + PG8_SA(b, h) + aoff + m * 2048 + k * 1024); } while (0)
#define PG8_LDB(dst, b, h) do { _Pragma("unroll") for (int n = 0; n < 2; ++n) _Pragma("unroll") for (int k = 0; k < 2; ++k) dst[n][k] = *(const LAS bf16x8*)(lds + PG8_SB(b, h) + boff + n * 2048 + k * 1024); } while (0)
#define PG8_MMA(ai, bj, At, Bt) do { __builtin_amdgcn_s_setprio(1); _Pragma("unroll") for (int m = 0; m < 4; ++m) _Pragma("unroll") for (int n = 0; n < 2; ++n) _Pragma("unroll") for (int k = 0; k < 2; ++k) \
        acc[ai][bj][m][n] = __builtin_amdgcn_mfma_f32_16x16x32_bf16(Bt[n][k], At[m][k], acc[ai][bj][m][n], 0, 0, 0); __builtin_amdgcn_s_setprio(0); } while (0)
#define PG8_WAIT_V(n) asm volatile("s_waitcnt vmcnt(" #n ")" ::: "memory")
#define PG8_WAIT_L(n) asm volatile("s_waitcnt lgkmcnt(" #n ")" ::: "memory")
#define PG8_BAR __builtin_amdgcn_s_barrier()
#define PG8_SCHED __builtin_amdgcn_sched_barrier(0)
    Unit cur, nxt; int ui = 0;
    if (!S.next(0, cur)) return;
    f32x4 acc[2][2][4][2];
#pragma unroll
    for (int a = 0; a < 2; ++a)
#pragma unroll
        for (int b = 0; b < 2; ++b)
#pragma unroll
            for (int m = 0; m < 4; ++m)
#pragma unroll
                for (int n = 0; n < 2; ++n) acc[a][b][m][n] = (f32x4){0.f, 0.f, 0.f, 0.f};
    bf16x8 At[4][2], B0[2][2], B1[2][2];
    const char* cA = (const char*)g.A + (size_t)cur.pm * tstep; const char* cB = (const char*)g.Bt + (size_t)cur.pn * tstep;
#if GEMM_SP2
    PG8_STAGE(PG8_SB(0, 0), cB, voffB); PG8_STAGE(PG8_SB(0, 1), cB + hstep, voffB); PG8_STAGE(PG8_SA(0, 0), cA, voffA); PG8_STAGE(PG8_SA(0, 1), cA + hstep, voffA);
    if (wr == 1) PG8_BAR;
    PG8_WAIT_V(2); PG8_BAR;
#else
    PG8_STAGE(PG8_SB(0, 0), cB, voffB); PG8_STAGE(PG8_SA(0, 0), cA, voffA); PG8_STAGE(PG8_SB(0, 1), cB + hstep, voffB); PG8_STAGE(PG8_SA(0, 1), cA + hstep, voffA);
    if (wr == 1) PG8_BAR;
    PG8_WAIT_V(4); PG8_BAR;
#endif
    PG8_STAGE(PG8_SB(1, 0), cB + kstep, voffB); PG8_STAGE(PG8_SA(1, 0), cA + kstep, voffA); PG8_STAGE(PG8_SB(1, 1), cB + hstep + kstep, voffB);
    PG8_WAIT_V(6); PG8_BAR;
    for (;;) {
        const bool has_next = S.next(ui + 1, nxt);
        const char* nA = has_next ? (const char*)g.A + (size_t)nxt.pm * tstep : cA; const char* nB = has_next ? (const char*)g.Bt + (size_t)nxt.pn * tstep : cB;
        for (int t = 0; t < nt; t += 2) {
            const bool last = (t == nt - 2);
            const char* a1 = cA + (size_t)(t + 1) * kstep;
            const char* a2 = last ? nA : cA + (size_t)(t + 2) * kstep; const char* b2 = last ? nB : cB + (size_t)(t + 2) * kstep;
            const char* a3 = a2 + kstep; const char* b3 = b2 + kstep;
#if GEMM_SP2
            PG8_LDB(B0, 0, 0); PG8_LDB(B1, 0, 1); PG8_SCHED; PG8_LDA(At, 0, 0); PG8_STAGE(PG8_SA(1, 1), a1 + hstep, voffA);
            PG8_WAIT_V(8); PG8_WAIT_L(0); PG8_BAR; PG8_MMA(0, 0, At, B0); PG8_MMA(0, 1, At, B1); PG8_BAR; PG8_SCHED;
            PG8_LDA(At, 0, 1); PG8_STAGE(PG8_SB(0, 0), b2, voffB); PG8_STAGE(PG8_SB(0, 1), b2 + hstep, voffB); PG8_STAGE(PG8_SA(0, 0), a2, voffA);
            PG8_WAIT_V(8); PG8_WAIT_L(0); PG8_BAR; PG8_MMA(1, 0, At, B0); PG8_MMA(1, 1, At, B1); PG8_BAR; PG8_SCHED;
            PG8_LDB(B0, 1, 0); PG8_LDB(B1, 1, 1); PG8_SCHED; PG8_LDA(At, 1, 0); PG8_STAGE(PG8_SA(0, 1), a2 + hstep, voffA);
            PG8_WAIT_V(8); PG8_WAIT_L(0); PG8_BAR; PG8_MMA(0, 0, At, B0); PG8_MMA(0, 1, At, B1); PG8_BAR; PG8_SCHED;
            PG8_LDA(At, 1, 1); PG8_STAGE(PG8_SB(1, 0), b3, voffB); PG8_STAGE(PG8_SB(1, 1), b3 + hstep, voffB); PG8_STAGE(PG8_SA(1, 0), a3, voffA);
            PG8_WAIT_V(8); PG8_WAIT_L(0); PG8_BAR; PG8_MMA(1, 0, At, B0); PG8_MMA(1, 1, At, B1); PG8_BAR; PG8_SCHED;
#else
            PG8_LDB(B0, 0, 0); PG8_SCHED; PG8_LDA(At, 0, 0); PG8_STAGE(PG8_SA(1, 1), a1 + hstep, voffA);
            PG8_WAIT_L(8); PG8_BAR; PG8_WAIT_L(0); PG8_MMA(0, 0, At, B0); PG8_BAR; PG8_SCHED;
            PG8_LDB(B1, 0, 1); PG8_STAGE(PG8_SB(0, 0), b2, voffB);
            PG8_BAR; PG8_WAIT_L(0); PG8_MMA(0, 1, At, B1); PG8_BAR;
            PG8_LDA(At, 0, 1); PG8_STAGE(PG8_SA(0, 0), a2, voffA);
            PG8_BAR; PG8_WAIT_L(0); PG8_MMA(1, 0, At, B0); PG8_BAR; PG8_SCHED;
            PG8_STAGE(PG8_SB(0, 1), b2 + hstep, voffB);
            PG8_WAIT_V(6); PG8_BAR; PG8_MMA(1, 1, At, B1); PG8_BAR;
            PG8_LDB(B0, 1, 0); PG8_SCHED; PG8_LDA(At, 1, 0); PG8_STAGE(PG8_SA(0, 1), a2 + hstep, voffA);
            PG8_WAIT_L(8); PG8_BAR; PG8_WAIT_L(0); PG8_MMA(0, 0, At, B0); PG8_BAR; PG8_SCHED;
            PG8_LDB(B1, 1, 1); PG8_STAGE(PG8_SB(1, 0), b3, voffB);
            PG8_BAR; PG8_WAIT_L(0); PG8_MMA(0, 1, At, B1); PG8_BAR;
            PG8_LDA(At, 1, 1); PG8_STAGE(PG8_SA(1, 0), a3, voffA);
            PG8_BAR; PG8_WAIT_L(0); PG8_MMA(1, 0, At, B0); PG8_BAR; PG8_SCHED;
            PG8_STAGE(PG8_SB(1, 1), b3 + hstep, voffB);
            PG8_WAIT_V(6); PG8_BAR; PG8_MMA(1, 1, At, B1); PG8_BAR;
#endif
        }
        if (wr == 0) PG8_BAR;
        E(acc, cur, wr, wc, fr, fq);
        if (!has_next) break;
#pragma unroll
        for (int a = 0; a < 2; ++a)
#pragma unroll
            for (int b = 0; b < 2; ++b)
#pragma unroll
                for (int m = 0; m < 4; ++m)
#pragma unroll
                    for (int n = 0; n < 2; ++n) acc[a][b][m][n] = (f32x4){0.f, 0.f, 0.f, 0.f};
        cur = nxt; cA = nA; cB = nB; ++ui;
        if (wr == 1) PG8_BAR;
    }
    PG8_WAIT_V(0);
    PG8_BAR;
#undef PG8_SA
#undef PG8_SB
#undef PG8_STAGE
#undef PG8_LDA
#undef PG8_LDB
#undef PG8_MMA
#undef PG8_WAIT_V
#undef PG8_WAIT_L
#undef PG8_BAR
#undef PG8_SCHED
}
}

__device__ __forceinline__ void prep_weights(LAS unsigned char* lds, const Params& p) {
    LAS float* t = (LAS float*)lds;
    const int tid = tid_op();
    const int G = (int)gridDim.x;
    int id = (int)blockIdx.x;
    if (id >= 4992) return;
#define PW_DECODE(id_, W_, Wt_, N_, K_, k0_, n0_, dn0_) do { int loc; \
        if ((id_) < 1408) { W_ = p.w_in_even; N_ = 5632; K_ = 1024; loc = (id_); Wt_ = (bf16_t*)(p.ws + OFF_WT0); } \
        else if ((id_) < 1920) { W_ = p.w_out_even; N_ = 1024; K_ = 2048; loc = (id_) - 1408; Wt_ = (bf16_t*)(p.ws + OFF_WT0O); } \
        else if ((id_) < 4480) { W_ = p.w_in_odd; N_ = 10240; K_ = 1024; loc = (id_) - 1920; Wt_ = (bf16_t*)(p.ws + OFF_WT1); } \
        else { W_ = p.w_out_odd; N_ = 1024; K_ = 2048; loc = (id_) - 4480; Wt_ = (bf16_t*)(p.ws + OFF_WT1O); } \
        const int nn = N_ >> 6, kt = loc / nn; n0_ = (loc - kt * nn) * 64; k0_ = kt * 64; dn0_ = n0_; \
        if ((id_) < 1408) { if (n0_ >= 4608) dn0_ = n0_ - 256; else if (n0_ >= 4352) dn0_ = n0_ + 1024; } \
        else if ((id_) >= 1920 && (id_) < 4480) { if (n0_ >= 8192) dn0_ = n0_ - 2048; else if (n0_ >= 6144) dn0_ = n0_ + 2048; } } while (0)
    const float* W; bf16_t* Wt; int N, K, k0, n0, dn0;
    PW_DECODE(id, W, Wt, N, K, k0, n0, dn0);
    f32x4 v[2];
#pragma unroll
    for (int i = 0; i < 2; ++i) { const int idx = tid + i * 512, r = idx >> 4, c4 = idx & 15; v[i] = *(const f32x4*)(W + (size_t)(k0 + r) * N + n0 + c4 * 4); }
    for (;;) {
#pragma unroll
        for (int i = 0; i < 2; ++i) { const int idx = tid + i * 512, r = idx >> 4, c4 = idx & 15;
            t[r * 65 + c4 * 4 + 0] = v[i][0]; t[r * 65 + c4 * 4 + 1] = v[i][1]; t[r * 65 + c4 * 4 + 2] = v[i][2]; t[r * 65 + c4 * 4 + 3] = v[i][3]; }
        const int id2 = id + G;
        const float* W2 = W; bf16_t* Wt2 = Wt; int N2 = N, K2 = K, k02 = k0, n02 = n0, dn02 = dn0;
        if (id2 < 4992) { PW_DECODE(id2, W2, Wt2, N2, K2, k02, n02, dn02);
#pragma unroll
            for (int i = 0; i < 2; ++i) { const int idx = tid + i * 512, r = idx >> 4, c4 = idx & 15; v[i] = *(const f32x4*)(W2 + (size_t)(k02 + r) * N2 + n02 + c4 * 4); } }
        __syncthreads();
        { const int n = tid >> 3, k8 = tid & 7;
          float e[8];
#pragma unroll
          for (int j = 0; j < 8; ++j) e[j] = t[(k8 * 8 + j) * 65 + n];
          u32x4 w; w.x = cvt_pk_bf16(e[0], e[1]); w.y = cvt_pk_bf16(e[2], e[3]); w.z = cvt_pk_bf16(e[4], e[5]); w.w = cvt_pk_bf16(e[6], e[7]);
          *(u32x4*)(Wt + (size_t)(dn0 + n) * K + k0 + k8 * 8) = w; }
        __syncthreads();
        if (id2 >= 4992) break;
        id = id2; W = W2; Wt = Wt2; N = N2; K = K2; k0 = k02; n0 = n02; dn0 = dn02;
    }
#undef PW_DECODE
}
__device__ __forceinline__ void rms_rows_bf16(const float* X, const float* g, bf16_t* H, int nrows) {
    const int tid = tid_op(), lane = tid & 63, wv = tid >> 6;
    f32x4 gg[4];
#pragma unroll
    for (int i = 0; i < 4; ++i) gg[i] = ((const f32x4*)g)[i * 64 + lane];
    for (int r0 = (blockIdx.x * 8 + wv) * 4; r0 < nrows; r0 += gridDim.x * 32) {
        f32x4 v[4][4];
#pragma unroll
        for (int q = 0; q < 4; ++q)
#pragma unroll
            for (int i = 0; i < 4; ++i) v[q][i] = __builtin_nontemporal_load((const f32x4*)(X + (size_t)(r0 + q) * 1024) + i * 64 + lane);
#pragma unroll
        for (int q = 0; q < 4; ++q) {
            float ss = 0.f;
#pragma unroll
            for (int i = 0; i < 4; ++i) ss += v[q][i][0] * v[q][i][0] + v[q][i][1] * v[q][i][1] + v[q][i][2] * v[q][i][2] + v[q][i][3] * v[q][i][3];
#pragma unroll
            for (int o = 32; o >= 1; o >>= 1) ss += __shfl_xor(ss, o);
            const float rs = rsqrtf(ss * (1.0f / 1024.0f) + 1e-6f);
#pragma unroll
            for (int i = 0; i < 4; ++i) {
                u32x2 w; w.x = cvt_pk_bf16(v[q][i][0] * rs * gg[i][0], v[q][i][1] * rs * gg[i][1]); w.y = cvt_pk_bf16(v[q][i][2] * rs * gg[i][2], v[q][i][3] * rs * gg[i][3]);
                *(u32x2*)(H + (size_t)(r0 + q) * 1024 + (i * 64 + lane) * 4) = w; }
        }
    }
}
__device__ __forceinline__ void rms_rows_f32_inplace(float* X, const float* g, int nrows) {
    const int tid = tid_op(), lane = tid & 63, wv = tid >> 6;
    f32x4 gg[4];
#pragma unroll
    for (int i = 0; i < 4; ++i) gg[i] = ((const f32x4*)g)[i * 64 + lane];
    for (int r0 = (blockIdx.x * 8 + wv) * 4; r0 < nrows; r0 += gridDim.x * 32) {
        f32x4 v[4][4];
#pragma unroll
        for (int q = 0; q < 4; ++q)
#pragma unroll
            for (int i = 0; i < 4; ++i) v[q][i] = __builtin_nontemporal_load((const f32x4*)(X + (size_t)(r0 + q) * 1024) + i * 64 + lane);
#pragma unroll
        for (int q = 0; q < 4; ++q) {
            float ss = 0.f;
#pragma unroll
            for (int i = 0; i < 4; ++i) ss += v[q][i][0] * v[q][i][0] + v[q][i][1] * v[q][i][1] + v[q][i][2] * v[q][i][2] + v[q][i][3] * v[q][i][3];
#pragma unroll
            for (int o = 32; o >= 1; o >>= 1) ss += __shfl_xor(ss, o);
            const float rs = rsqrtf(ss * (1.0f / 1024.0f) + 1e-6f);
#pragma unroll
            for (int i = 0; i < 4; ++i) ((f32x4*)(X + (size_t)(r0 + q) * 1024))[i * 64 + lane] = v[q][i] * rs * gg[i];
        }
    }
}

__device__ __forceinline__ void att_phase(LAS unsigned char* lds, const Params& p) {
    const int tid = tid_op(), w = tid >> 6, lane = tid & 63, l15 = lane & 15, quad = lane >> 4;
    const bf16_t* proj0 = (const bf16_t*)(p.ws + OFF_PROJ0); const bf16_t* vbt = (const bf16_t*)(p.ws + OFF_VBT); bf16_t* mix0 = (bf16_t*)(p.ws + OFF_MIX0);
    LAS unsigned char* Ks = lds; LAS unsigned char* Vs = lds + 32768; LAS unsigned char* Ps = lds + 65536;
    const float scale = 0.08838834764831845f;
    const int tl = w * 16 + l15;
    const int fb0 = FRAG_BASE(2048, 0), fb1 = FRAG_BASE(2048, 1);
    const int G = (int)gridDim.x;
    int it = (int)blockIdx.x;
    if (it >= 4096) return;
    u32x4 kreg[4], vreg[4]; bf16x8 qnext[4];
#define ATT_LOADKV(b_, nb_, hk_) do { const size_t _st = (size_t)(b_) * SEQ + (size_t)(nb_) * 128; \
        _Pragma("unroll") for (int i = 0; i < 4; ++i) { const int idx = tid + i * 512, r = idx >> 4, c = idx & 15; \
            kreg[i] = *(const u32x4*)(proj0 + (_st + r) * N0 + 4096 + (hk_) * 128 + c * 8); \
            vreg[i] = *(const u32x4*)(vbt + (size_t)((hk_) * 128 + r) * MTOK + _st + c * 8); } } while (0)
#define ATT_LOADQ(b_, n_, hq_) do { const bf16_t* qp = proj0 + ((size_t)(b_) * SEQ + (size_t)(n_) * 128 + w * 16 + l15) * N0 + 3072 + (hq_) * 128 + quad * 8; \
        _Pragma("unroll") for (int k = 0; k < 4; ++k) qnext[k] = *(const bf16x8*)(qp + k * 32); } while (0)
    int b = it >> 9, n = (it >> 3) & 63, hq = it & 7;
    int kb = (n == 0) ? 0 : -1;
    ATT_LOADQ(b, n, hq); ATT_LOADKV(b, n + kb, hq >> 2);
    for (;;) {
        bf16x8 qf[4];
#pragma unroll
        for (int k = 0; k < 4; ++k) qf[k] = qnext[k];
        float m = p.sink[hq], l = 1.0f;
        f32x4 oacc[8];
#pragma unroll
        for (int i = 0; i < 8; ++i) oacc[i] = (f32x4){0.f, 0.f, 0.f, 0.f};
        const float slope = exp2f(-(float)(hq + 1));
        const int kb_last = (n == 63) ? 0 : 1;
        const int it2 = it + G;
        for (;;) {
            __syncthreads();
#pragma unroll
            for (int i = 0; i < 4; ++i) { const int idx = tid + i * 512, r = idx >> 4, c = idx & 15;
                *(LAS u32x4*)(Ks + img_off(r, c, 2048)) = kreg[i]; *(LAS u32x4*)(Vs + img_off(r, c, 2048)) = vreg[i]; }
            if (kb != kb_last) { ATT_LOADKV(b, n + kb + 1, hq >> 2); }
            else if (it2 < 4096) { const int b2 = it2 >> 9, n2 = (it2 >> 3) & 63, hq2 = it2 & 7; ATT_LOADQ(b2, n2, hq2); ATT_LOADKV(b2, n2 + ((n2 == 0) ? 0 : -1), hq2 >> 2); }
            __syncthreads();
            f32x4 sc[8];
#pragma unroll
            for (int sp = 0; sp < 4; ++sp) {
                bf16x8 kf[2][4];
#pragma unroll
                for (int i = 0; i < 2; ++i)
#pragma unroll
                    for (int k = 0; k < 4; ++k) kf[i][k] = *(const LAS bf16x8*)(Ks + ((k & 1) ? fb1 : fb0) + (sp * 2 + i) * 256 + k * 8192);
                __builtin_amdgcn_sched_barrier(0);
                f32x4 a0 = (f32x4){0.f, 0.f, 0.f, 0.f}, a1 = (f32x4){0.f, 0.f, 0.f, 0.f};
#pragma unroll
                for (int k = 0; k < 4; ++k) { a0 = mfma16(kf[0][k], qf[k], a0); a1 = mfma16(kf[1][k], qf[k], a1); }
                sc[sp * 2] = a0; sc[sp * 2 + 1] = a1;
                __builtin_amdgcn_sched_barrier(0);
            }
            float mx = -1e30f;
#pragma unroll
            for (int st = 0; st < 8; ++st)
#pragma unroll
                for (int jj = 0; jj < 4; ++jj) { const int sl = st * 16 + quad * 4 + jj; int dist = tl - sl - kb * 128; dist = dist < 0 ? -dist : dist;
                    float v = sc[st][jj] * scale - slope * (float)dist; v = dist <= 128 ? v : -1e30f; sc[st][jj] = v; mx = fmaxf(mx, v); }
            mx = fmaxf(mx, __shfl_xor(mx, 16)); mx = fmaxf(mx, __shfl_xor(mx, 32));
            const float mn = fmaxf(m, mx), alpha = __expf(m - mn); float rs = 0.f;
#pragma unroll
            for (int st = 0; st < 8; ++st)
#pragma unroll
                for (int jj = 0; jj < 4; ++jj) { const float pv = __expf(sc[st][jj] - mn); sc[st][jj] = pv; rs += pv; }
            rs += __shfl_xor(rs, 16); rs += __shfl_xor(rs, 32);
            l = l * alpha + rs; m = mn;
#pragma unroll
            for (int dt = 0; dt < 8; ++dt) oacc[dt] = oacc[dt] * alpha;
#pragma unroll
            for (int st = 0; st < 8; ++st) { u32x2 wv; wv.x = cvt_pk_bf16(sc[st][0], sc[st][1]); wv.y = cvt_pk_bf16(sc[st][2], sc[st][3]);
                *(LAS u32x2*)(Ps + img_off(tl, st * 2 + (quad >> 1), 2048) + (quad & 1) * 8) = wv; }
            asm volatile("s_waitcnt lgkmcnt(0)" ::: "memory");
            const int wh = w >> 1;
#pragma unroll
            for (int k = 0; k < 4; ++k) {
                const bool pv_ok = kb < 0 ? (k >= wh) : (kb > 0 ? (k <= wh) : true);
                if (pv_ok) {
                    const bf16x8 pf = *(const LAS bf16x8*)(Ps + ((k & 1) ? fb1 : fb0) + w * 256 + k * 8192);
                    bf16x8 vf[8];
#pragma unroll
                    for (int dt = 0; dt < 8; ++dt) vf[dt] = *(const LAS bf16x8*)(Vs + ((k & 1) ? fb1 : fb0) + dt * 256 + k * 8192);
                    __builtin_amdgcn_sched_barrier(0);
#pragma unroll
                    for (int dt = 0; dt < 8; ++dt) oacc[dt] = mfma16(vf[dt], pf, oacc[dt]);
                    __builtin_amdgcn_sched_barrier(0);
                }
            }
            if (kb == kb_last) break;
            ++kb;
        }
        { const float inv = 1.0f / l;
          const size_t tok = (size_t)b * SEQ + (size_t)n * 128 + tl;
#pragma unroll
          for (int dt = 0; dt < 8; ++dt) { const int d = dt * 16 + quad * 4;
              const u32x2 zz = *(const u32x2*)(proj0 + tok * N0 + 4352 + hq * 128 + d);
              const float o0 = oacc[dt][0] * inv * siluf_(bf_lo(zz.x)), o1 = oacc[dt][1] * inv * siluf_(bf_hi(zz.x)), o2 = oacc[dt][2] * inv * siluf_(bf_lo(zz.y)), o3 = oacc[dt][3] * inv * siluf_(bf_hi(zz.y));
              u32x2 wv; wv.x = cvt_pk_bf16(o0, o1); wv.y = cvt_pk_bf16(o2, o3);
              *(u32x2*)(mix0 + tok * 2048 + 1024 + hq * 128 + d) = wv; } }
        it = it2; if (it >= 4096) break;
        b = it >> 9; n = (it >> 3) & 63; hq = it & 7; kb = (n == 0) ? 0 : -1;
    }
#undef ATT_LOADKV
#undef ATT_LOADQ
}

__device__ __forceinline__ void sgu_item(LAS unsigned char* lds, const Params& p, int b, int n, int g) {
    const int tid = tid_op(), w = tid >> 6, lane = tid & 63, l15 = lane & 15, quad = lane >> 4;
    const bf16_t* proj0 = (const bf16_t*)(p.ws + OFF_PROJ0); bf16_t* mix0 = (bf16_t*)(p.ws + OFF_MIX0);
    const size_t tok0 = (size_t)b * SEQ + (size_t)n * 128;
    LAS unsigned char* VnT = lds; LAS unsigned char* Ws = lds + 65536;
    u32x2 upre[16], zpre[16];
    { const bf16_t* up = proj0 + (tok0 + w * 16 + l15) * N0 + g * 256 + quad * 4;
#pragma unroll
      for (int ct = 0; ct < 16; ++ct) { upre[ct] = *(const u32x2*)(up + ct * 16); zpre[ct] = *(const u32x2*)(up + 2048 + ct * 16); } }
    __syncthreads();
    { const float* wp = p.w_s + (size_t)g * 16384;
#pragma unroll
      for (int i = 0; i < 8; ++i) { const int idx = tid + i * 512, r = idx >> 5, c4 = idx & 31; const f32x4 v = *(const f32x4*)(wp + r * 128 + c4 * 4);
          u32x2 wv; wv.x = cvt_pk_bf16(v[0], v[1]); wv.y = cvt_pk_bf16(v[2], v[3]); *(LAS u32x2*)(Ws + img_off(r, c4 >> 1, 2048) + (c4 & 1) * 8) = wv; } }
    __syncthreads();
    {
      const int sidx = tid & 127;
      float s_ = 0.f, ss = 0.f;
      { const f32x4* sp = (const f32x4*)((const float*)(p.ws + OFF_STATP) + (tok0 + sidx) * 32);
#pragma unroll
        for (int q = 0; q < 8; ++q) { const f32x4 t4 = sp[q]; s_ += t4[0] + t4[2]; ss += t4[1] + t4[3]; } }
      const float mu = s_ * (1.0f / 1024.0f), rstd = rsqrtf(fmaxf(ss * (1.0f / 1024.0f) - mu * mu, 0.f) + 1e-6f);
#pragma unroll
      for (int i = 0; i < 8; ++i) { const int c8 = (tid >> 7) + i * 4;
          const u32x4 v = *(const u32x4*)(proj0 + (tok0 + sidx) * N0 + 1024 + g * 256 + c8 * 8);
          const f32x4 g0 = *(const f32x4*)(p.ln_g + g * 256 + c8 * 8), g1 = *(const f32x4*)(p.ln_g + g * 256 + c8 * 8 + 4);
          const f32x4 b0 = *(const f32x4*)(p.ln_b + g * 256 + c8 * 8), b1 = *(const f32x4*)(p.ln_b + g * 256 + c8 * 8 + 4);
          float e[8];
#pragma unroll
          for (int j = 0; j < 4; ++j) { e[2 * j] = (bf_lo(v[j]) - mu) * rstd; e[2 * j + 1] = (bf_hi(v[j]) - mu) * rstd; }
#pragma unroll
          for (int j = 0; j < 4; ++j) { e[j] = e[j] * g0[j] + b0[j]; e[4 + j] = e[4 + j] * g1[j] + b1[j]; }
#pragma unroll
          for (int j = 0; j < 8; ++j) *(LAS unsigned short*)(VnT + img_off(c8 * 8 + j, sidx >> 3, 4096) + (sidx & 7) * 2) = (unsigned short)cvt_pk_bf16(e[j], 0.f); } }
    __syncthreads();
    bf16x8 wf[4];
#pragma unroll
    for (int k = 0; k < 4; ++k) wf[k] = *(const LAS bf16x8*)(Ws + FRAG_BASE(2048, k & 1) + w * 256 + k * 8192);
    const int vb0 = FRAG_BASE(4096, 0), vb1 = FRAG_BASE(4096, 1);
    const int t = w * 16 + l15; const size_t tok = tok0 + t; const float bs = p.b_s[g * 128 + t];
#pragma unroll
    for (int cp = 0; cp < 8; ++cp) {
      bf16x8 vf[2][4];
#pragma unroll
      for (int i = 0; i < 2; ++i)
#pragma unroll
          for (int k = 0; k < 4; ++k) vf[i][k] = *(const LAS bf16x8*)(VnT + ((k & 1) ? vb1 : vb0) + (cp * 2 + i) * 256 + k * 16384);
      __builtin_amdgcn_sched_barrier(0);
      f32x4 a2[2] = {(f32x4){0.f, 0.f, 0.f, 0.f}, (f32x4){0.f, 0.f, 0.f, 0.f}};
#pragma unroll
      for (int k = 0; k < 4; ++k) { a2[0] = mfma16(vf[0][k], wf[k], a2[0]); a2[1] = mfma16(vf[1][k], wf[k], a2[1]); }
      __builtin_amdgcn_sched_barrier(0);
#pragma unroll
      for (int i = 0; i < 2; ++i) { const int ct = cp * 2 + i; const f32x4 a = a2[i];
        const int c = g * 256 + ct * 16 + quad * 4;
        const u32x2 uu = upre[ct], zz = zpre[ct];
        const float o0 = bf_lo(uu.x) * (a[0] + bs) * siluf_(bf_lo(zz.x)), o1 = bf_hi(uu.x) * (a[1] + bs) * siluf_(bf_hi(zz.x));
        const float o2 = bf_lo(uu.y) * (a[2] + bs) * siluf_(bf_lo(zz.y)), o3 = bf_hi(uu.y) * (a[3] + bs) * siluf_(bf_hi(zz.y));
        u32x2 wv; wv.x = cvt_pk_bf16(o0, o1); wv.y = cvt_pk_bf16(o2, o3);
        *(u32x2*)(mix0 + tok * 2048 + c) = wv; } }
}

constexpr int SC_KT = 16384, SC_KTT = 32768, SC_IT = 49152, SC_DN = 57344, SC_SET = 57856;
constexpr int SC_AL = 2 * SC_SET, SC_ST = SC_AL + 8192, SC_SEG = SC_ST + 16384, SC_END = SC_SEG + 4096;
__device__ __forceinline__ void scan_item(LAS unsigned char* lds, const Params& p, int item) {
    const int tid = tid_op(), w = tid >> 6, lane = tid & 63, l15 = lane & 15, quad = lane >> 4;
    const int bl = item >> 6, h = (item >> 2) & 15, dir = (item >> 1) & 1, vh = item & 1;
    const bf16_t* proj1 = (const bf16_t*)(p.ws + OFF_PROJ1); const bf16_t* itg = (const bf16_t*)(p.ws + OFF_IT);
    bf16_t* og = (bf16_t*)(p.ws + (dir ? OFF_OB : OFF_OF));
    const int col = h * 128 + 2 * lane;
    LAS unsigned char* Al = lds + SC_AL; LAS unsigned char* ST = lds + SC_ST; LAS float* segp = (LAS float*)(lds + SC_SEG);
    const size_t rowbase = (size_t)bl * SEQ;
    const bf16_t* fbase = proj1 + (rowbase + w * 8) * N1 + col + 2048 + dir * 2048;
    const bf16_t* qbase = proj1 + (rowbase + w * 8) * N1 + col;
    const bf16_t* ibase = itg + (size_t)(h * 128 + vh * 64 + (tid >> 3)) * MH + rowbase + (tid & 7) * 8;
    const bool mma_first = (w & 4) != 0;
    const int tt = w >> 1;
    const int fa0 = FRAG_BASE(1024, 0), fa1 = FRAG_BASE(1024, 1), fk0 = FRAG_BASE(2048, 0), fk1 = FRAG_BASE(2048, 1);
    f32x4 sacc[4];
#pragma unroll
    for (int i = 0; i < 4; ++i) sacc[i] = (f32x4){0.f, 0.f, 0.f, 0.f};
    unsigned fraw[8], qraw[8]; u32x4 iraw;
    f32x2 kv[8], cv[8];
    bf16x8 qf[4];
#define SC_LOAD_F(n_) do { const size_t _ro = (size_t)(n_) * 64 * N1; _Pragma("unroll") for (int j = 0; j < 8; ++j) fraw[j] = *(const unsigned*)(fbase + _ro + (size_t)j * N1); } while (0)
#define SC_LOAD_QI(n_) do { const size_t _ro = (size_t)(n_) * 64 * N1; _Pragma("unroll") for (int j = 0; j < 8; ++j) qraw[j] = *(const unsigned*)(qbase + _ro + (size_t)j * N1); \
        iraw = *(const u32x4*)(ibase + (size_t)(n_) * 64); } while (0)
#define SC_LOAD(n_) do { SC_LOAD_F(n_); SC_LOAD_QI(n_); } while (0)
#define SC_GATE_A() do { _Pragma("unroll") for (int j = 0; j < 8; ++j) { cv[j] = (f32x2){bf_lo(fraw[j]), bf_hi(fraw[j])}; kv[j] = 1.0f - cv[j]; } \
        if (!dir) { _Pragma("unroll") for (int j = 1; j < 8; ++j) cv[j] = cv[j] * cv[j - 1]; } else { _Pragma("unroll") for (int j = 6; j >= 0; --j) cv[j] = cv[j] * cv[j + 1]; } \
        *(LAS f32x2*)(segp + w * 128 + 2 * lane) = dir ? cv[0] : cv[7]; } while (0)
#define SC_GATE_B(SET_) do { LAS unsigned char* _set = lds + (SET_) * SC_SET; f32x2 off = (f32x2){1.f, 1.f}, tot = (f32x2){1.f, 1.f}; \
        _Pragma("unroll") for (int w2 = 0; w2 < 8; ++w2) { const f32x2 tv = *(const LAS f32x2*)(segp + w2 * 128 + 2 * lane); tot = tot * tv; const bool before = dir ? (w2 > w) : (w2 < w); off = off * (before ? tv : (f32x2){1.f, 1.f}); } \
        f32x2 kt[8]; \
        _Pragma("unroll") for (int j = 0; j < 8; ++j) { const f32x2 P = off * cv[j]; const f32x2 ip = (f32x2){__builtin_amdgcn_rcpf(P[0]), __builtin_amdgcn_rcpf(P[1])}; kt[j] = kv[j] * ip; \
            const f32x2 qt = (f32x2){bf_lo(qraw[j]), bf_hi(qraw[j])} * P; \
            *(LAS unsigned*)(_set + img_off(w * 8 + j, lane >> 2, 1024) + (lane & 3) * 4) = cvt_pk_bf16(qt[0], qt[1]); \
            *(LAS unsigned*)(_set + SC_KT + img_off(w * 8 + j, lane >> 2, 1024) + (lane & 3) * 4) = cvt_pk_bf16(kt[j][0], kt[j][1]); } \
        { u32x4 e; e.x = cvt_pk_bf16(kt[0][0], kt[1][0]); e.y = cvt_pk_bf16(kt[2][0], kt[3][0]); e.z = cvt_pk_bf16(kt[4][0], kt[5][0]); e.w = cvt_pk_bf16(kt[6][0], kt[7][0]); \
          *(LAS u32x4*)(_set + SC_KTT + img_off(2 * lane, w, 2048)) = e; \
          e.x = cvt_pk_bf16(kt[0][1], kt[1][1]); e.y = cvt_pk_bf16(kt[2][1], kt[3][1]); e.z = cvt_pk_bf16(kt[4][1], kt[5][1]); e.w = cvt_pk_bf16(kt[6][1], kt[7][1]); \
          *(LAS u32x4*)(_set + SC_KTT + img_off(2 * lane + 1, w, 2048)) = e; } \
        if (w == 0) *(LAS f32x2*)(_set + SC_DN + lane * 8) = tot; \
        *(LAS u32x4*)(_set + SC_IT + img_off(tid >> 3, tid & 7, 1024)) = iraw; } while (0)
#define SC_MMA1(SET_) do { const LAS unsigned char* _set = lds + (SET_) * SC_SET; bf16x8 kf[2][4]; \
        _Pragma("unroll") for (int k = 0; k < 4; ++k) qf[k] = *(const LAS bf16x8*)(_set + ((k & 1) ? fa1 : fa0) + tt * 256 + k * 4096); \
        _Pragma("unroll") for (int i = 0; i < 2; ++i) _Pragma("unroll") for (int k = 0; k < 4; ++k) kf[i][k] = *(const LAS bf16x8*)(_set + SC_KT + ((k & 1) ? fa1 : fa0) + ((w & 1) * 2 + i) * 256 + k * 4096); \
        __builtin_amdgcn_sched_barrier(0); \
        f32x4 a0 = (f32x4){0.f, 0.f, 0.f, 0.f}, a1 = (f32x4){0.f, 0.f, 0.f, 0.f}; \
        _Pragma("unroll") for (int k = 0; k < 4; ++k) { a0 = mfma16(kf[0][k], qf[k], a0); a1 = mfma16(kf[1][k], qf[k], a1); } \
        __builtin_amdgcn_sched_barrier(0); \
        const int t = tt * 16 + l15; \
        _Pragma("unroll") for (int i = 0; i < 2; ++i) { const int st = (w & 1) * 2 + i; f32x4 a = i ? a1 : a0; \
            _Pragma("unroll") for (int jj = 0; jj < 4; ++jj) { const int s_ = st * 16 + quad * 4 + jj; const bool ok = dir ? (s_ >= t) : (s_ <= t); a[jj] = ok ? a[jj] : 0.f; } \
            u32x2 wv; wv.x = cvt_pk_bf16(a[0], a[1]); wv.y = cvt_pk_bf16(a[2], a[3]); \
            *(LAS u32x2*)(Al + img_off(t, st * 2 + (quad >> 1), 1024) + (quad & 1) * 8) = wv; } } while (0)
#define SC_MMA2(SET_, n_) do { const LAS unsigned char* _set = lds + (SET_) * SC_SET; \
        bf16x8 vf[4][2]; \
        { bf16x8 af[2], sf[2][4]; \
          _Pragma("unroll") for (int k = 0; k < 2; ++k) af[k] = *(const LAS bf16x8*)(Al + ((k & 1) ? fa1 : fa0) + tt * 256 + k * 4096); \
          _Pragma("unroll") for (int vt = 0; vt < 4; ++vt) _Pragma("unroll") for (int k = 0; k < 2; ++k) vf[vt][k] = *(const LAS bf16x8*)(_set + SC_IT + ((k & 1) ? fa1 : fa0) + vt * 256 + k * 4096); \
          _Pragma("unroll") for (int i = 0; i < 2; ++i) _Pragma("unroll") for (int k = 0; k < 4; ++k) sf[i][k] = *(const LAS bf16x8*)(ST + ((k & 1) ? fa1 : fa0) + ((w & 1) * 2 + i) * 256 + k * 4096); \
          __builtin_amdgcn_sched_barrier(0); \
          f32x4 o0 = (f32x4){0.f, 0.f, 0.f, 0.f}, o1 = (f32x4){0.f, 0.f, 0.f, 0.f}, p0 = (f32x4){0.f, 0.f, 0.f, 0.f}, p1 = (f32x4){0.f, 0.f, 0.f, 0.f}; \
          _Pragma("unroll") for (int k = 0; k < 2; ++k) { if (w & 1) { p0 = mfma16(vf[2][k], af[k], p0); p1 = mfma16(vf[3][k], af[k], p1); } else { p0 = mfma16(vf[0][k], af[k], p0); p1 = mfma16(vf[1][k], af[k], p1); } } \
          _Pragma("unroll") for (int k = 0; k < 4; ++k) { o0 = mfma16(sf[0][k], qf[k], o0); o1 = mfma16(sf[1][k], qf[k], o1); } \
          __builtin_amdgcn_sched_barrier(0); \
          o0 = o0 + p0; o1 = o1 + p1; \
          const size_t r = rowbase + (size_t)(n_) * 64 + tt * 16 + l15; \
          u32x2 wv; wv.x = cvt_pk_bf16(o0[0], o0[1]); wv.y = cvt_pk_bf16(o0[2], o0[3]); \
          *(u32x2*)(og + r * 2048 + h * 128 + vh * 64 + ((w & 1) * 2) * 16 + quad * 4) = wv; \
          wv.x = cvt_pk_bf16(o1[0], o1[1]); wv.y = cvt_pk_bf16(o1[2], o1[3]); \
          *(u32x2*)(og + r * 2048 + h * 128 + vh * 64 + ((w & 1) * 2 + 1) * 16 + quad * 4) = wv; } \
        { const f32x4 dv = *(const LAS f32x4*)(_set + SC_DN + (w * 16 + quad * 4) * 4); \
          bf16x8 ktf[2]; \
          _Pragma("unroll") for (int k = 0; k < 2; ++k) ktf[k] = *(const LAS bf16x8*)(_set + SC_KTT + ((k & 1) ? fk1 : fk0) + w * 256 + k * 8192); \
          __builtin_amdgcn_sched_barrier(0); \
          _Pragma("unroll") for (int k = 0; k < 2; ++k) _Pragma("unroll") for (int vt = 0; vt < 4; ++vt) sacc[vt] = mfma16(ktf[k], vf[vt][k], sacc[vt]); \
          __builtin_amdgcn_sched_barrier(0); \
          _Pragma("unroll") for (int vt = 0; vt < 4; ++vt) sacc[vt] = sacc[vt] * dv; } } while (0)
#define SC_ST_WRITE() do { _Pragma("unroll") for (int vt = 0; vt < 4; ++vt) { u32x2 wv; wv.x = cvt_pk_bf16(sacc[vt][0], sacc[vt][1]); wv.y = cvt_pk_bf16(sacc[vt][2], sacc[vt][3]); \
        *(LAS u32x2*)(ST + img_off(vt * 16 + l15, w * 2 + (quad >> 1), 1024) + (quad & 1) * 8) = wv; } } while (0)

    __syncthreads();
    SC_LOAD(dir ? 127 : 0);
    SC_GATE_A();
    __syncthreads();
    SC_GATE_B(0);
    SC_LOAD(dir ? 126 : 1);
    __syncthreads();
#pragma unroll 2
    for (int c = 0; c < 128; ++c) {
        const int n = dir ? 127 - c : c, cur = c & 1;
        SC_ST_WRITE();
        if (mma_first) { SC_MMA1(cur); if (c + 1 < 128) SC_GATE_A(); if (c + 2 < 128) SC_LOAD_F(dir ? 125 - c : c + 2); }
        else { if (c + 1 < 128) SC_GATE_A(); if (c + 2 < 128) SC_LOAD_F(dir ? 125 - c : c + 2); SC_MMA1(cur); }
        __syncthreads();
        if (mma_first) { SC_MMA2(cur, n); if (c + 1 < 128) { SC_GATE_B(cur ^ 1); if (c + 2 < 128) SC_LOAD_QI(dir ? 125 - c : c + 2); } }
        else { if (c + 1 < 128) { SC_GATE_B(cur ^ 1); if (c + 2 < 128) SC_LOAD_QI(dir ? 125 - c : c + 2); } SC_MMA2(cur, n); }
        __syncthreads();
    }
#undef SC_LOAD
#undef SC_LOAD_F
#undef SC_LOAD_QI
#undef SC_GATE_A
#undef SC_GATE_B
#undef SC_MMA1
#undef SC_MMA2
#undef SC_ST_WRITE
}

__device__ __forceinline__ void gate_phase(const Params& p) {
    const int tid = tid_op(), sub = tid & 15, grp = tid >> 4;
    bf16_t* of = (bf16_t*)(p.ws + OFF_OF); const bf16_t* ob = (const bf16_t*)(p.ws + OFF_OB); const bf16_t* proj1 = (const bf16_t*)(p.ws + OFF_PROJ1);
    const int h = grp & 15, col = h * 128 + sub * 8;
    const f32x4 g0 = *(const f32x4*)(p.head_g + col), g1 = *(const f32x4*)(p.head_g + col + 4);
    for (int it0 = blockIdx.x * 4; it0 < MH / 2; it0 += gridDim.x * 4) {
        u32x4 a[4], b[4], z[4];
#pragma unroll
        for (int q = 0; q < 4; ++q) { const size_t tokl = (size_t)(it0 + q) * 2 + (grp >> 4);
            a[q] = __builtin_nontemporal_load((const u32x4*)(of + tokl * 2048 + col)); b[q] = __builtin_nontemporal_load((const u32x4*)(ob + tokl * 2048 + col)); z[q] = __builtin_nontemporal_load((const u32x4*)(proj1 + tokl * N1 + 6144 + col)); }
#pragma unroll
        for (int q = 0; q < 4; ++q) { const size_t tokl = (size_t)(it0 + q) * 2 + (grp >> 4);
            float o[8]; float ss = 0.f;
#pragma unroll
            for (int j = 0; j < 4; ++j) { o[2 * j] = bf_lo(a[q][j]) + bf_lo(b[q][j]); o[2 * j + 1] = bf_hi(a[q][j]) + bf_hi(b[q][j]); ss += o[2 * j] * o[2 * j] + o[2 * j + 1] * o[2 * j + 1]; }
            ss += __shfl_xor(ss, 1); ss += __shfl_xor(ss, 2); ss += __shfl_xor(ss, 4); ss += __shfl_xor(ss, 8);
            const float rs = rsqrtf(ss * (1.0f / 128.0f) + 1e-6f);
            u32x4 wv;
#pragma unroll
            for (int j = 0; j < 4; ++j) { const float gl = j < 2 ? g0[2 * j] : g1[2 * j - 4], gh = j < 2 ? g0[2 * j + 1] : g1[2 * j - 3];
                wv[j] = cvt_pk_bf16(o[2 * j] * rs * gl * siluf_(bf_lo(z[q][j])), o[2 * j + 1] * rs * gh * siluf_(bf_hi(z[q][j]))); }
            *(u32x4*)(of + tokl * 2048 + col) = wv; }
    }
}

__device__ __forceinline__ void run_gemm(LAS unsigned char* lds, const bf16_t* A, const bf16_t* Bt, int M, int N, int K, const pg8::Epi& E) {
    pg8::Gemm g; g.A = A; g.Bt = Bt; g.M = M; g.N = N; g.K = K;
    pg8::StaticOrder S; S.init(M, N, (int)gridDim.x, (int)blockIdx.x);
    pg8::gemm_phase(lds, g, S, E);
}

__device__ __forceinline__ void grid_bar(unsigned* ctr, unsigned target) {
    __syncthreads();
    if (threadIdx.x == 0) {
        __builtin_amdgcn_fence(__ATOMIC_RELEASE, "agent");
        const unsigned g = blockIdx.x & 7u, gsz = (gridDim.x - g + 7u) >> 3;
        const unsigned old = __hip_atomic_fetch_add(ctr + 16 + 16 * g, 1u, __ATOMIC_RELAXED, __HIP_MEMORY_SCOPE_AGENT);
        if ((old + 1u) % gsz == 0u) __hip_atomic_fetch_add(ctr, gsz, __ATOMIC_RELAXED, __HIP_MEMORY_SCOPE_AGENT);
        while (__hip_atomic_load(ctr, __ATOMIC_RELAXED, __HIP_MEMORY_SCOPE_AGENT) < target) __builtin_amdgcn_s_sleep(1);
        __builtin_amdgcn_fence(__ATOMIC_ACQUIRE, "agent");
    }
    __syncthreads();
}
__device__ __forceinline__ void grid_arrive(unsigned* ctr) {
    __syncthreads();
    if (threadIdx.x == 0) { __threadfence(); __hip_atomic_fetch_add(ctr, 1u, __ATOMIC_RELAXED, __HIP_MEMORY_SCOPE_AGENT); }
}
__device__ __forceinline__ void grid_wait(unsigned* ctr, unsigned target) {
    if (threadIdx.x == 0) { while (__hip_atomic_load(ctr, __ATOMIC_RELAXED, __HIP_MEMORY_SCOPE_AGENT) < target) __builtin_amdgcn_s_sleep(1); __threadfence(); }
    __syncthreads();
}
__device__ __forceinline__ void sgu_stats(const Params& p) {
    const int tid = tid_op(), lane = tid & 63, wv = tid >> 6;
    const bf16_t* proj0 = (const bf16_t*)(p.ws + OFF_PROJ0); float* stat = (float*)(p.ws + OFF_STAT);
    for (int r0 = (blockIdx.x * 8 + wv) * 4; r0 < MTOK; r0 += gridDim.x * 32) {
        u32x4 a[4], b[4];
#pragma unroll
        for (int q = 0; q < 4; ++q) { a[q] = *(const u32x4*)(proj0 + (size_t)(r0 + q) * N0 + 1024 + lane * 8); b[q] = *(const u32x4*)(proj0 + (size_t)(r0 + q) * N0 + 1536 + lane * 8); }
#pragma unroll
        for (int q = 0; q < 4; ++q) {
            float s_ = 0.f, ss = 0.f;
#pragma unroll
            for (int j = 0; j < 4; ++j) { const float x0 = bf_lo(a[q][j]), x1 = bf_hi(a[q][j]), x2 = bf_lo(b[q][j]), x3 = bf_hi(b[q][j]); s_ += (x0 + x1) + (x2 + x3); ss += (x0 * x0 + x1 * x1) + (x2 * x2 + x3 * x3); }
#pragma unroll
            for (int o = 32; o >= 1; o >>= 1) { s_ += __shfl_xor(s_, o); ss += __shfl_xor(ss, o); }
            const float mu = s_ * (1.0f / 1024.0f), var = fmaxf(ss * (1.0f / 1024.0f) - mu * mu, 0.f);
            if (lane == 0) *(f32x2*)(stat + (size_t)(r0 + q) * 2) = (f32x2){mu, rsqrtf(var + 1e-6f)};
        }
    }
}
__global__ void __launch_bounds__(512, 2) mega(Params p) {
    extern __shared__ __attribute__((aligned(16))) unsigned char shm[];
    LAS unsigned char* lds = (LAS unsigned char*)shm;
    cg::grid_group grid = cg::this_grid();
    unsigned char* ws = p.ws;
    int nbar = 0;
#if PROBE_SYNCS
    for (int i = 0; i < PROBE_SYNCS; ++i) grid.sync();
#endif
    for (int ph2 = p.ph_lo * 2; ph2 < p.ph_hi * 2; ++ph2) {
        const int ph = ph2 >> 1;
        if ((ph2 & 1) && !((REPEAT_MASK >> ph) & 1)) continue;
        if (ph == 9) continue;
        if (ph2 > p.ph_lo * 2) {
            if (nbar == 0) grid.sync();
            else grid_bar((unsigned*)(ws + OFF_BAR), (unsigned)nbar * gridDim.x);
            ++nbar;
        }
        const int hb = ph >= 9 ? 1 : 0;
        const bool is_gemm = (ph == 1 || ph == 3 || ph == 5 || ph == 8 || ph == 9 || ph == 12);
        if (is_gemm) {
            const int ng = (ph == 8) ? 3 : (ph == 1 || ph == 5) ? 2 : 1;
            for (int gj = 0; gj < ng; ++gj) {
                const int gi = (ph == 8) ? gj - 1 : gj;
                const bf16_t* A; const bf16_t* Bt; int M, N, K; pg8::Epi E; E.mode = 0; E.O = nullptr; E.ldo = 0; E.silu_cols = 0; E.C = nullptr; E.R = nullptr; E.ldc = 0; E.lbv = nullptr; E.f_lo = 0; E.f_hi = 0; E.statp = nullptr; E.s_lo = 0; E.s_hi = 0;
                if (ph == 1) {
                    K = 1024;
                    if (gi == 0) { A = (const bf16_t*)(ws + OFF_H0); Bt = (const bf16_t*)(ws + OFF_WT0); M = MTOK; N = N0; E.O = (bf16_t*)(ws + OFF_PROJ0); E.ldo = N0; E.statp = (float*)(ws + OFF_STATP); E.s_lo = 1024; E.s_hi = 2048; }
                    else { A = (const bf16_t*)(ws + OFF_WT0) + (size_t)N0 * 1024; Bt = (const bf16_t*)(ws + OFF_H0); M = 256; N = MTOK; E.O = (bf16_t*)(ws + OFF_VBT); E.ldo = MTOK; }
                } else if (ph == 3) {
                    K = 2048; A = (const bf16_t*)(ws + OFF_MIX0); Bt = (const bf16_t*)(ws + OFF_WT0O); M = MTOK; N = 1024; E.mode = 1; E.C = p.out; E.R = p.x; E.ldc = 1024;
                } else if (ph == 5 || (ph == 8 && gj > 0)) {
                    K = 1024;
                    if (gi == 0) { A = (const bf16_t*)(ws + OFF_H1); Bt = (const bf16_t*)(ws + OFF_WT1); M = MH; N = N1; E.O = (bf16_t*)(ws + OFF_PROJ1); E.ldo = N1; E.silu_cols = 2048; E.lbv = (const float*)(ws + OFF_LB); E.f_lo = 2048; E.f_hi = 6144; }
                    else { A = (const bf16_t*)(ws + OFF_WT1) + (size_t)N1 * 1024; Bt = (const bf16_t*)(ws + OFF_H1); M = 2048; N = MH; E.O = (bf16_t*)(ws + OFF_IT); E.ldo = MH; }
                } else {
                    K = 2048; A = (const bf16_t*)(ws + OFF_OF); Bt = (const bf16_t*)(ws + OFF_WT1O); M = MH; N = 1024; E.mode = 1;
                    float* o = p.out + (size_t)(ph == 12 ? 1 : 0) * MH * 1024; E.C = o; E.R = o; E.ldc = 1024;
                }
#ifndef NO_GEMM
                run_gemm(lds, A, Bt, M, N, K, E);
#endif
            }
        } else if (ph == 0) {
            { float* lbt = (float*)(ws + OFF_LB);
              for (int i = blockIdx.x * 512 + tid_op(); i < 4096; i += gridDim.x * 512) { const float* gm = i < 2048 ? p.gamma_f : p.gamma_b; const int cc = i & 2047; lbt[i] = sigmoidf_(gm[2048 + cc] - gm[cc]); } }
            prep_weights(lds, p);
            rms_rows_bf16(p.x, p.norm_g_even, (bf16_t*)(ws + OFF_H0), MTOK);
        } else if (ph == 2) {
#ifndef NO_ATT
            att_phase(lds, p);
#endif
#ifndef NO_SGU
            for (int j = blockIdx.x; j < 2048; j += gridDim.x) sgu_item(lds, p, j >> 8, (j >> 2) & 63, j & 3);
#endif
        } else if (ph == 4) {
            rms_rows_bf16(p.out, p.norm_g_odd, (bf16_t*)(ws + OFF_H1), MH);
        } else if (ph == 6 || ph == 10) {
            Params q = p; q.ws = ws;
#ifndef NO_SCAN
            for (int it = blockIdx.x; it < 256; it += gridDim.x) {
                const int item = (gridDim.x == 256) ? (((it & 7) * 8 + (it >> 5)) * 4 + ((it >> 3) & 3)) : it;
                scan_item(lds, q, item); }
#endif
        } else if (ph == 7 || ph == 11) {
            gate_phase(p);
            if (ph == 7) rms_rows_bf16(p.out + (size_t)MH * 1024, p.norm_g_odd, (bf16_t*)(ws + OFF_H1), MH);
        } else if (ph == 13) {
            rms_rows_f32_inplace(p.out, p.final_g, MTOK);
        }
        (void)hb;
    }
}

extern "C" void kernel_launch(void* const* d_in, const int* in_sizes, int n_in, void* d_out, int out_size, void* d_ws, size_t ws_size, hipStream_t stream) {
    static int grid = 0;
    if (grid == 0) {
        if (n_in != 16 || out_size != MTOK * DM || ws_size < WS_NEED) { fprintf(stderr, "kernel_launch: unexpected shapes (n_in %d out %d ws %zu)\n", n_in, out_size, ws_size); grid = -1; return; }
        int dev = 0, cus = 0, per_cu = 0;
        hipGetDevice(&dev); hipDeviceGetAttribute(&cus, hipDeviceAttributeMultiprocessorCount, dev);
        hipFuncSetAttribute((const void*)mega, hipFuncAttributeMaxDynamicSharedMemorySize, LDS_BYTES);
        hipOccupancyMaxActiveBlocksPerMultiprocessor(&per_cu, (const void*)mega, 512, LDS_BYTES);
        if (per_cu < 1) per_cu = 1;
        grid = cus * per_cu;
        (void)hipGetLastError();
    }
    if (grid < 0) return;
    hipMemsetAsync((unsigned char*)d_ws + OFF_BAR, 0, 1024, stream);
    Params p{};
    p.x = (const float*)d_in[0]; p.norm_g_even = (const float*)d_in[1]; p.w_in_even = (const float*)d_in[2]; p.ln_g = (const float*)d_in[3]; p.ln_b = (const float*)d_in[4];
    p.w_s = (const float*)d_in[5]; p.b_s = (const float*)d_in[6]; p.sink = (const float*)d_in[7]; p.w_out_even = (const float*)d_in[8]; p.norm_g_odd = (const float*)d_in[9];
    p.w_in_odd = (const float*)d_in[10]; p.gamma_f = (const float*)d_in[11]; p.gamma_b = (const float*)d_in[12]; p.head_g = (const float*)d_in[13]; p.w_out_odd = (const float*)d_in[14];
    p.final_g = (const float*)d_in[15]; p.out = (float*)d_out; p.ws = (unsigned char*)d_ws;
#if N_LAUNCH_MODE == 1
    p.ph_lo = 0; p.ph_hi = NPHASE;
    void* args[] = {&p};
    hipError_t e = hipLaunchCooperativeKernel((const void*)mega, dim3(grid), dim3(512), args, LDS_BYTES, stream);
    if (e != hipSuccess) fprintf(stderr, "cooperative launch failed: %s (grid %d)\n", hipGetErrorString(e), grid);
#else
    for (int ph = 0; ph < NPHASE; ++ph) { if (PH_SKIP(ph)) continue; p.ph_lo = ph; p.ph_hi = ph + 1; hipLaunchKernelGGL(mega, dim3(grid), dim3(512), LDS_BYTES, stream, p); }
#endif
}
```
